# Optimizing an MI355X kernel written in HIP

```python
import math
import jax, jax.numpy as jnp
from jax import lax
import numpy as np

D_MODEL = 1024
BATCH = 4
SEQ = 8192
DEPTH = 1

CHUNK = 64
MIX_WIDTH = D_MODEL
GDN_HEADS = 4
GDN_DK = D_MODEL // 8
GDN_DV = D_MODEL // 8
GDN_WIDTH = GDN_HEADS * GDN_DV
CONV_K = 4
DIFF_HEADS = 4
DIFF_D = D_MODEL // 16
DIFF_WIDTH = DIFF_HEADS * 2 * DIFF_D
ROPE_THETA = 500000.0
ROT_DIM = DIFF_D // 4
Q_BLOCK = 128
NORM_EPS = 1e-6
SPLIT_SIZES = (GDN_HEADS * GDN_DK, GDN_HEADS * GDN_DK, GDN_WIDTH,
               GDN_HEADS, GDN_HEADS, GDN_WIDTH,
               DIFF_WIDTH, DIFF_WIDTH, DIFF_WIDTH, DIFF_WIDTH)
IN_WIDTH = sum(SPLIT_SIZES)

kernel_name = 'hybrid_gdn_diffattn_parallel_heads'


def rms_norm(x, g):
    xf = x.astype(jnp.float32)
    y = xf * lax.rsqrt(jnp.mean(xf * xf, axis=-1, keepdims=True) + NORM_EPS)
    return (y * g.astype(jnp.float32)).astype(x.dtype)


def l2_norm(x):
    return x * lax.rsqrt(jnp.sum(x * x, axis=-1, keepdims=True) + NORM_EPS)


def causal_dwconv(u, w):
    return lax.conv_general_dilated(u, w[:, None, :].astype(u.dtype), window_strides=(1,),
                                    padding=[(CONV_K - 1, 0)],
                                    dimension_numbers=('NWC', 'WIO', 'NWC'),
                                    feature_group_count=u.shape[-1])


def gated_delta_rule_chunked(q, k, v, beta, g):
    b, s, h, dk = q.shape
    dv = v.shape[-1]
    n = s // CHUNK

    def to_chunks(t):
        return t.reshape(b, n, CHUNK, h, -1).transpose(0, 3, 1, 2, 4)

    q, k, v = to_chunks(q), to_chunks(k), to_chunks(v)
    beta = beta.reshape(b, n, CHUNK, h).transpose(0, 3, 1, 2)
    gc = jnp.cumsum(g.reshape(b, n, CHUNK, h).transpose(0, 3, 1, 2), axis=-1)
    incl = jnp.tril(jnp.ones((CHUNK, CHUNK), dtype=bool))
    strict = jnp.tril(jnp.ones((CHUNK, CHUNK), dtype=bool), k=-1)
    decay = jnp.exp(jnp.where(incl, gc[..., :, None] - gc[..., None, :], -jnp.inf))
    kb = k * beta[..., None]
    vb = v * beta[..., None]
    m = jnp.where(strict, jnp.einsum('bhnid,bhnjd->bhnij', kb, k) * decay, 0.0)
    lhs = m + jnp.eye(CHUNK, dtype=m.dtype)
    rhs = jnp.concatenate([vb, kb * jnp.exp(gc)[..., None]], axis=-1)
    sol = lax.linalg.triangular_solve(lhs, rhs, left_side=True, lower=True, unit_diagonal=True)
    u, w = sol[..., :dv], sol[..., dv:]
    a_intra = jnp.einsum('bhnid,bhnjd->bhnij', q, k) * decay
    q_dec = q * jnp.exp(gc)[..., None]
    k_dec = k * jnp.exp(gc[..., -1:] - gc)[..., None]
    g_last = jnp.exp(gc[..., -1])
    xs = tuple(jnp.moveaxis(t, 2, 0) for t in (w, u, q_dec, k_dec, a_intra, g_last))

    def step(state, inp):
        w_n, u_n, qd_n, kd_n, a_n, gl_n = inp
        v_new = u_n - jnp.einsum('bhcd,bhde->bhce', w_n, state)
        o = jnp.einsum('bhcd,bhde->bhce', qd_n, state) + jnp.einsum('bhcs,bhse->bhce', a_n, v_new)
        state = state * gl_n[..., None, None] + jnp.einsum('bhcd,bhce->bhde', kd_n, v_new)
        return state, o

    state0 = jnp.zeros((b, h, dk, dv), jnp.float32)
    _, o = lax.scan(step, state0, xs)
    return o.transpose(1, 0, 3, 2, 4).reshape(b, s, h, dv)


def gdn_branch(q, k, v, beta_pre, decay_pre, conv_w, a_log, dt_bias, out_g):
    b, s, _ = q.shape
    qkv = jax.nn.silu(causal_dwconv(jnp.concatenate([q, k, v], axis=-1), conv_w)).astype(jnp.float32)
    nk = GDN_HEADS * GDN_DK
    qf = l2_norm(qkv[..., :nk].reshape(b, s, GDN_HEADS, GDN_DK)) * (GDN_DK ** -0.5)
    kf = l2_norm(qkv[..., nk:2 * nk].reshape(b, s, GDN_HEADS, GDN_DK))
    vf = qkv[..., 2 * nk:].reshape(b, s, GDN_HEADS, GDN_DV)
    beta = jax.nn.sigmoid(beta_pre.astype(jnp.float32))
    g = -jnp.exp(a_log.astype(jnp.float32)) * jax.nn.softplus(
        decay_pre.astype(jnp.float32) + dt_bias.astype(jnp.float32))
    o = gated_delta_rule_chunked(qf, kf, vf, beta, g)
    o = rms_norm(o, out_g)
    return o.reshape(b, s, GDN_WIDTH)


def apply_partial_rope(x, cos, sin):
    half = ROT_DIM // 2
    xr = x[..., :ROT_DIM].astype(jnp.float32)
    x1, x2 = xr[..., :half], xr[..., half:]
    rot = jnp.concatenate([x1 * cos - x2 * sin, x2 * cos + x1 * sin], axis=-1)
    return jnp.concatenate([rot.astype(x.dtype), x[..., ROT_DIM:]], axis=-1)


def diff_attention_branch(q, k, v, positions, q_norm_g, k_norm_g, lam_q1, lam_k1, lam_q2, lam_k2,
                          subln_g, lambda_init):
    b, s, _ = q.shape
    q = rms_norm(q.reshape(b, s, DIFF_HEADS, 2, DIFF_D), q_norm_g)
    k = rms_norm(k.reshape(b, s, DIFF_HEADS, 2, DIFF_D), k_norm_g)
    v = v.reshape(b, s, DIFF_HEADS, 2 * DIFF_D)
    inv_freq = ROPE_THETA ** (-jnp.arange(0, ROT_DIM, 2, dtype=jnp.float32) / ROT_DIM)
    ang = positions.astype(jnp.float32)[..., None] * inv_freq
    cos = jnp.cos(ang)[:, :, None, None, :]
    sin = jnp.sin(ang)[:, :, None, None, :]
    q = apply_partial_rope(q, cos, sin)
    k = apply_partial_rope(k, cos, sin)
    lam = (jnp.exp(jnp.sum(lam_q1.astype(jnp.float32) * lam_k1.astype(jnp.float32)))
           - jnp.exp(jnp.sum(lam_q2.astype(jnp.float32) * lam_k2.astype(jnp.float32)))
           + lambda_init)
    qh = q.transpose(0, 2, 3, 1, 4)
    kh = k.transpose(0, 2, 3, 1, 4)
    vh = v.transpose(0, 2, 1, 3).astype(jnp.float32)
    nq = s // Q_BLOCK
    qblocks = qh.reshape(b, DIFF_HEADS, 2, nq, Q_BLOCK, DIFF_D).transpose(3, 0, 1, 2, 4, 5)
    key_chunk = jnp.arange(s) // CHUNK
    scale = DIFF_D ** -0.5

    def block(args):
        qb, bi = args
        q_chunk = (bi * Q_BLOCK + jnp.arange(Q_BLOCK)) // CHUNK
        mask = key_chunk[None, :] <= q_chunk[:, None]
        sc = jnp.einsum('bhiqd,bhikd->bhiqk', qb, kh).astype(jnp.float32) * scale
        p = jax.nn.softmax(jnp.where(mask, sc, -jnp.inf), axis=-1)
        a = p[:, :, 0] - lam * p[:, :, 1]
        return jnp.einsum('bhqk,bhke->bhqe', a, vh)

    o = lax.map(block, (qblocks, jnp.arange(nq)))
    o = o.transpose(1, 0, 3, 2, 4).reshape(b, s, DIFF_HEADS, 2 * DIFF_D)
    o = rms_norm(o, subln_g) * (1.0 - lambda_init)
    return o.reshape(b, s, DIFF_WIDTH)


def hybrid_layer(x, c, positions, lambda_init, norm_g, w_ada, b_ada, w_in, conv_w, a_log, dt_bias,
                 gdn_norm_g, q_norm_g, k_norm_g, lam_q1, lam_k1, lam_q2, lam_k2, subln_g, w_out):
    mod = jax.nn.silu(c) @ w_ada + b_ada
    shift, scale, gate = jnp.split(mod, 3, axis=-1)
    h = rms_norm(x, norm_g) * (1.0 + scale[:, None, :]) + shift[:, None, :]
    proj = h @ w_in
    idx = [int(i) for i in np.cumsum(SPLIT_SIZES)[:-1]]
    a_q, a_k, a_v, a_beta, a_decay, a_gate, b_q, b_k, b_v, b_gate = jnp.split(proj, idx, axis=-1)
    o_a = gdn_branch(a_q, a_k, a_v, a_beta, a_decay, conv_w, a_log, dt_bias, gdn_norm_g)
    o_b = diff_attention_branch(b_q, b_k, b_v, positions, q_norm_g, k_norm_g,
                                lam_q1, lam_k1, lam_q2, lam_k2, subln_g, lambda_init)
    mixed = jnp.concatenate([o_a.astype(x.dtype) * jax.nn.silu(a_gate),
                             o_b.astype(x.dtype) * jax.nn.silu(b_gate)], axis=-1)
    return x + gate[:, None, :] * (mixed @ w_out)


def setup_inputs(seed: int = 0) -> dict:
    key = jax.random.key(seed)
    ks = jax.random.split(key, 20)
    f32 = jnp.float32
    L, D = DEPTH, D_MODEL
    x = jax.random.normal(ks[0], (BATCH, SEQ, D), f32)
    c = jax.random.normal(ks[1], (BATCH, D), f32)
    positions = jnp.broadcast_to(jnp.arange(SEQ, dtype=jnp.int32)[None, :], (BATCH, SEQ))
    norm_g = 1.0 + 0.01 * jax.random.normal(ks[2], (L, D), f32)
    w_ada = 0.5 * D ** -0.5 * jax.random.normal(ks[3], (L, D, 3 * D), f32)
    b_ada = 0.01 * jax.random.normal(ks[4], (L, 3 * D), f32)
    w_in = D ** -0.5 * jax.random.normal(ks[5], (L, D, IN_WIDTH), f32)
    conv_w = CONV_K ** -0.5 * jax.random.normal(ks[6], (L, CONV_K, 2 * GDN_HEADS * GDN_DK + GDN_WIDTH), f32)
    a_log = jnp.log(jax.random.uniform(ks[7], (L, GDN_HEADS), f32, 1.0, 16.0))
    dt = jnp.exp(jax.random.uniform(ks[8], (L, GDN_HEADS), f32, math.log(0.001), math.log(0.1)))
    dt_bias = dt + jnp.log(-jnp.expm1(-dt))
    gdn_norm_g = 1.0 + 0.01 * jax.random.normal(ks[9], (L, GDN_DV), f32)
    q_norm_g = 1.0 + 0.01 * jax.random.normal(ks[10], (L, DIFF_D), f32)
    k_norm_g = 1.0 + 0.01 * jax.random.normal(ks[11], (L, DIFF_D), f32)
    lambda_q1 = 0.1 * jax.random.normal(ks[12], (L, DIFF_D), f32)
    lambda_k1 = 0.1 * jax.random.normal(ks[13], (L, DIFF_D), f32)
    lambda_q2 = 0.1 * jax.random.normal(ks[14], (L, DIFF_D), f32)
    lambda_k2 = 0.1 * jax.random.normal(ks[15], (L, DIFF_D), f32)
    subln_g = 1.0 + 0.01 * jax.random.normal(ks[16], (L, 2 * DIFF_D), f32)
    w_out = MIX_WIDTH ** -0.5 * jax.random.normal(ks[17], (L, MIX_WIDTH, D), f32)
    return {'x': x, 'c': c, 'positions': positions, 'norm_g': norm_g, 'w_ada': w_ada,
            'b_ada': b_ada, 'w_in': w_in, 'conv_w': conv_w, 'a_log': a_log, 'dt_bias': dt_bias,
            'gdn_norm_g': gdn_norm_g, 'q_norm_g': q_norm_g, 'k_norm_g': k_norm_g,
            'lambda_q1': lambda_q1, 'lambda_k1': lambda_k1, 'lambda_q2': lambda_q2,
            'lambda_k2': lambda_k2, 'subln_g': subln_g, 'w_out': w_out}


def reference(x, c, positions, norm_g, w_ada, b_ada, w_in, conv_w, a_log, dt_bias, gdn_norm_g,
              q_norm_g, k_norm_g, lambda_q1, lambda_k1, lambda_q2, lambda_k2, subln_g, w_out):
    for l in range(DEPTH):
        lambda_init = 0.8 - 0.6 * math.exp(-0.3 * l)
        x = hybrid_layer(x, c, positions, lambda_init, norm_g[l], w_ada[l], b_ada[l], w_in[l],
                         conv_w[l], a_log[l], dt_bias[l], gdn_norm_g[l], q_norm_g[l], k_norm_g[l],
                         lambda_q1[l], lambda_k1[l], lambda_q2[l], lambda_k2[l], subln_g[l], w_out[l])
    return x
```

```cpp
#include <hip/hip_runtime.h>
#include <hip/hip_cooperative_groups.h>
#include <cstdio>
#include <cstdint>
namespace cg = cooperative_groups;
namespace pg8 {
#define PG8_LAS __attribute__((address_space(3)))
typedef unsigned short bf16_t;
typedef short bf16x8 __attribute__((ext_vector_type(8)));
typedef float f32x4 __attribute__((ext_vector_type(4)));
typedef unsigned u32x4 __attribute__((ext_vector_type(4)));
constexpr int BM = 256, BK = 64, HALF = 128, HTB = HALF * BK * 2  , STAGE_BYTES = 8 * HTB, NXCD = 8, WGM = 8;

__host__ __device__ __forceinline__ int lds_byte(int r, int c) { const int st = (r >> 4) * 2 + (c >> 5), rr = r & 15, cc = c & 31, ob = rr * 64 + cc * 2; return st * 1024 + (ob ^ (((ob >> 9) & 1) << 5)); }
__host__ __device__ __forceinline__ void stage_rc(int b, int& R, int& C) { const int st = b / 1024, sb = b % 1024, swz = sb ^ (((sb >> 9) & 1) << 5); R = (st >> 1) * 16 + swz / 64; C = (st & 1) * 32 + (swz % 64) / 2; }
__host__ __device__ __forceinline__ int perm32(int rho) { const int n = rho >> 4, i = rho & 15; return 8 * (i >> 2) + 4 * n + (i & 3); }

struct Unit { int pm, pn; };
struct Gemm { const bf16_t* A; const bf16_t* Bt; int M, N, K; };

struct StaticOrder {
    int nM, nN, nwg, G, c;
    __host__ __device__ void init(int M, int N, int G_, int c_) { nM = M / BM; nN = N / BM; nwg = nM * nN; G = G_; c = c_; }
    __host__ __device__ bool next(int i, Unit& u) const {
        const long L = (long)i * G + c; if (L >= nwg) return false;
        int wgid = (int)L; { const int q = nwg / NXCD, r = nwg % NXCD, xcd = wgid % NXCD, off = wgid / NXCD; wgid = (xcd < r ? xcd * (q + 1) : r * (q + 1) + (xcd - r) * q) + off; }
        const int nig = WGM * nN, gid = wgid / nig, fm = gid * WGM, gsz = (nM - fm) < WGM ? (nM - fm) : WGM;
        u.pm = fm + ((wgid % nig) % gsz); u.pn = (wgid % nig) / gsz; return true;
    }
    __device__ __forceinline__ void a_ready(const Unit&) const {}
    __device__ __forceinline__ void done(const Unit&) const {}
};

__device__ __forceinline__ unsigned cvt_pk_bf16(float lo, float hi) { unsigned r; asm volatile("v_cvt_pk_bf16_f32 %0, %1, %2" : "=v"(r) : "v"(lo), "v"(hi)); return r; }
typedef float f32x2 __attribute__((ext_vector_type(2)));
__device__ __forceinline__ f32x2 gelu_pk(f32x2 v) {
    const f32x2 av = __builtin_elementwise_abs(v), d = av * 0.2316418882f + 1.0f;
    f32x2 t; t.x = __builtin_amdgcn_rcpf(d.x); t.y = __builtin_amdgcn_rcpf(d.y);
    f32x2 q = t * 0.5307027145f + (-0.7265760135f); q = q * t + 0.7107068705f; q = q * t + (-0.142248368f); q = q * t + 0.127414796f; q = q * t;
    const f32x2 s = (v * v) * (-0.72134752044f);
    f32x2 e; e.x = __builtin_amdgcn_exp2f(s.x); e.y = __builtin_amdgcn_exp2f(s.y);
    const f32x2 m = v * (q * e), r = v - m;
    f32x2 o; o.x = v.x < 0.f ? m.x : r.x; o.y = v.y < 0.f ? m.y : r.y; return o;
}

template <int ACT  > struct EpiBf16 {
    static constexpr bool PERM = true, AFTER_DRAIN = false; static_assert(ACT == 0 || ACT == 1, "EpiBf16: ACT is 0 (none) or 1 (gelu_pk)");
    bf16_t* O; int ldc; const float* bias; int split_cols; size_t split_stride; float scale0;
    __device__ __forceinline__ void operator()(const f32x4 (&acc)[2][2][4][2], const Unit& u, int wr, int wc, int fr, int fq) const {
        const int row0 = u.pm * BM + wr * 64 + fr; int colt = u.pn * BM; bf16_t* base = O;
        float sc = 1.f; if (split_cols) { const int t = colt / split_cols; base += (size_t)t * split_stride; colt -= t * split_cols; if (t == 0) sc = scale0; }
        const int col0 = colt + wc * 32 + 8 * fq, bcol0 = u.pn * BM + wc * 32 + 8 * fq;
        f32x4 bv[2][2];
#pragma unroll
        for (int bj = 0; bj < 2; ++bj)
#pragma unroll
            for (int n = 0; n < 2; ++n) bv[bj][n] = bias ? *(const f32x4*)(bias + bcol0 + bj * HALF + 4 * n) : (f32x4){0.f, 0.f, 0.f, 0.f};
#pragma unroll
        for (int ai = 0; ai < 2; ++ai)
#pragma unroll
            for (int m = 0; m < 4; ++m) { bf16_t* rowp = base + (size_t)(row0 + ai * HALF + m * 16) * ldc + col0;
#pragma unroll
                for (int bj = 0; bj < 2; ++bj) { f32x4 v0 = acc[ai][bj][m][0] + bv[bj][0], v1 = acc[ai][bj][m][1] + bv[bj][1];
                    if (ACT == 1) { f32x2 a = gelu_pk((f32x2){v0[0], v0[1]}), b = gelu_pk((f32x2){v0[2], v0[3]}), c = gelu_pk((f32x2){v1[0], v1[1]}), d = gelu_pk((f32x2){v1[2], v1[3]});
                        v0 = (f32x4){a.x, a.y, b.x, b.y}; v1 = (f32x4){c.x, c.y, d.x, d.y}; }
                    v0 = v0 * sc; v1 = v1 * sc; u32x4 w; w.x = cvt_pk_bf16(v0[0], v0[1]); w.y = cvt_pk_bf16(v0[2], v0[3]); w.z = cvt_pk_bf16(v1[0], v1[1]); w.w = cvt_pk_bf16(v1[2], v1[3]);
                    *(u32x4*)(rowp + bj * HALF) = w; } }
    }
};
template <class Epi, class Sched, bool ALIGN_EPI = false, bool SP2 = false>
__device__ __forceinline__ void gemm_phase(PG8_LAS unsigned char* lds, const Gemm g, const Sched& S, const Epi& E) {
    const int tid = threadIdx.x, wid = __builtin_amdgcn_readfirstlane(tid >> 6), lane = tid & 63, wr = wid >> 2, wc = wid & 3, fr = lane & 15, fq = lane >> 4;
    const int K = g.K, nt = K / BK;
    unsigned voffA[2], voffB[2];
#pragma unroll
    for (int i = 0; i < 2; ++i) { int R, C; stage_rc(tid * 16 + i * 8192, R, C); const int Rb = Epi::PERM ? ((R & ~31) + perm32(R & 31)) : R;
        voffA[i] = (unsigned)(R * K + C) * 2u; voffB[i] = (unsigned)(Rb * K + C) * 2u; }
    const size_t kstep = (size_t)(BK * 2);
    const size_t hstep = (size_t)HALF * K * 2;
    const size_t tstep = 2 * hstep;
    const unsigned ldsw = (unsigned)wid * 1024u;
    const int aoff = lds_byte(wr * 64 + fr, fq * 8), boff = lds_byte(wc * 32 + fr, fq * 8);
#define PG8_SA(b, h) (((b) * 2 + (h)) * HTB)
#define PG8_SB(b, h) ((4 + (b) * 2 + (h)) * HTB)
#define PG8_STAGE(bufoff, gbase, voff) do { _Pragma("unroll") for (int _i = 0; _i < 2; ++_i) \
        __builtin_amdgcn_global_load_lds((const unsigned*)((const char*)(gbase) + (voff)[_i]), (PG8_LAS unsigned*)(lds + (bufoff) + ldsw + _i * 8192), 16, 0, 0); } while (0)
#define PG8_LDA(dst, b, h) do { _Pragma("unroll") for (int m = 0; m < 4; ++m) _Pragma("unroll") for (int k = 0; k < 2; ++k) dst[m][k] = *(const PG8_LAS bf16x8*)(lds + PG8_SA(b, h) + aoff + m * 2048 + k * 1024); } while (0)
#define PG8_LDB(dst, b, h) do { _Pragma("unroll") for (int n = 0; n < 2; ++n) _Pragma("unroll") for (int k = 0; k < 2; ++k) dst[n][k] = *(const PG8_LAS bf16x8*)(lds + PG8_SB(b, h) + boff + n * 2048 + k * 1024); } while (0)
#define PG8_MMA(ai, bj, At, Bt) do { __builtin_amdgcn_s_setprio(1); _Pragma("unroll") for (int m = 0; m < 4; ++m) _Pragma("unroll") for (int n = 0; n < 2; ++n) _Pragma("unroll") for (int k = 0; k < 2; ++k) \
        acc[ai][bj][m][n] = __builtin_amdgcn_mfma_f32_16x16x32_bf16(Bt[n][k], At[m][k], acc[ai][bj][m][n], 0, 0, 0); __builtin_amdgcn_s_setprio(0); } while (0)
#define PG8_WAIT_V(n) asm volatile("s_waitcnt vmcnt(" #n ")" ::: "memory")
#define PG8_WAIT_L(n) asm volatile("s_waitcnt lgkmcnt(" #n ")" ::: "memory")
#define PG8_BAR __builtin_amdgcn_s_barrier()
#define PG8_SCHED __builtin_amdgcn_sched_barrier(0)
    Unit cur, nxt; int ui = 0;
    if (!S.next(0, cur)) return;
    f32x4 acc[2][2][4][2];
#pragma unroll
    for (int a = 0; a < 2; ++a)
#pragma unroll
        for (int b = 0; b < 2; ++b)
#pragma unroll
            for (int m = 0; m < 4; ++m)
#pragma unroll
                for (int n = 0; n < 2; ++n) acc[a][b][m][n] = (f32x4){0.f, 0.f, 0.f, 0.f};
    bf16x8 At[4][2], B0[2][2], B1[2][2];
    const char* cA = (const char*)g.A + (size_t)cur.pm * tstep; const char* cB = (const char*)g.Bt + (size_t)cur.pn * tstep;
    S.a_ready(cur);
    if constexpr (SP2) {
        PG8_STAGE(PG8_SB(0, 0), cB, voffB); PG8_STAGE(PG8_SB(0, 1), cB + hstep, voffB); PG8_STAGE(PG8_SA(0, 0), cA, voffA); PG8_STAGE(PG8_SA(0, 1), cA + hstep, voffA);
        if (wr == 1) PG8_BAR;
        PG8_WAIT_V(2); PG8_BAR;
        PG8_STAGE(PG8_SB(1, 0), cB + kstep, voffB); PG8_STAGE(PG8_SA(1, 0), cA + kstep, voffA); PG8_STAGE(PG8_SB(1, 1), cB + hstep + kstep, voffB);
        PG8_WAIT_V(6); PG8_BAR;
    } else {
        PG8_STAGE(PG8_SB(0, 0), cB, voffB); PG8_STAGE(PG8_SA(0, 0), cA, voffA); PG8_STAGE(PG8_SB(0, 1), cB + hstep, voffB); PG8_STAGE(PG8_SA(0, 1), cA + hstep, voffA);
        if (wr == 1) PG8_BAR;
        PG8_WAIT_V(4); PG8_BAR;
        PG8_STAGE(PG8_SB(1, 0), cB + kstep, voffB); PG8_STAGE(PG8_SA(1, 0), cA + kstep, voffA); PG8_STAGE(PG8_SB(1, 1), cB + hstep + kstep, voffB);
        PG8_WAIT_V(6); PG8_BAR;
    }
    for (;;) {
        const bool has_next = S.next(ui + 1, nxt);
        const char* nA = has_next ? (const char*)g.A + (size_t)nxt.pm * tstep : cA; const char* nB = has_next ? (const char*)g.Bt + (size_t)nxt.pn * tstep : cB;
        for (int t = 0; t < nt; t += 2) {
            const bool last = (t == nt - 2);
            const char* a1 = cA + (size_t)(t + 1) * kstep;
            const char* a2 = last ? nA : cA + (size_t)(t + 2) * kstep; const char* b2 = last ? nB : cB + (size_t)(t + 2) * kstep;
            const char* a3 = a2 + kstep; const char* b3 = b2 + kstep;
            if (last && has_next) S.a_ready(nxt);
            if constexpr (SP2) {
            PG8_LDB(B0, 0, 0); PG8_LDB(B1, 0, 1); PG8_SCHED; PG8_LDA(At, 0, 0); PG8_STAGE(PG8_SA(1, 1), a1 + hstep, voffA);
            PG8_WAIT_V(8); PG8_WAIT_L(0); PG8_BAR; PG8_MMA(0, 0, At, B0); PG8_MMA(0, 1, At, B1); PG8_BAR; PG8_SCHED;
            PG8_LDA(At, 0, 1); PG8_STAGE(PG8_SB(0, 0), b2, voffB); PG8_STAGE(PG8_SB(0, 1), b2 + hstep, voffB); PG8_STAGE(PG8_SA(0, 0), a2, voffA);
            PG8_WAIT_V(8); PG8_WAIT_L(0); PG8_BAR; PG8_MMA(1, 0, At, B0); PG8_MMA(1, 1, At, B1); PG8_BAR; PG8_SCHED;
            PG8_LDB(B0, 1, 0); PG8_LDB(B1, 1, 1); PG8_SCHED; PG8_LDA(At, 1, 0); PG8_STAGE(PG8_SA(0, 1), a2 + hstep, voffA);
            PG8_WAIT_V(8); PG8_WAIT_L(0); PG8_BAR; PG8_MMA(0, 0, At, B0); PG8_MMA(0, 1, At, B1); PG8_BAR; PG8_SCHED;
            PG8_LDA(At, 1, 1); PG8_STAGE(PG8_SB(1, 0), b3, voffB); PG8_STAGE(PG8_SB(1, 1), b3 + hstep, voffB); PG8_STAGE(PG8_SA(1, 0), a3, voffA);
            PG8_WAIT_V(8); PG8_WAIT_L(0); PG8_BAR; PG8_MMA(1, 0, At, B0); PG8_MMA(1, 1, At, B1); PG8_BAR; PG8_SCHED;
            } else {
            PG8_LDB(B0, 0, 0); PG8_SCHED; PG8_LDA(At, 0, 0); PG8_STAGE(PG8_SA(1, 1), a1 + hstep, voffA);
            PG8_WAIT_L(8); PG8_BAR; PG8_WAIT_L(0); PG8_MMA(0, 0, At, B0); PG8_BAR; PG8_SCHED;
            PG8_LDB(B1, 0, 1); PG8_STAGE(PG8_SB(0, 0), b2, voffB);
            PG8_BAR; PG8_WAIT_L(0); PG8_MMA(0, 1, At, B1); PG8_BAR;
            PG8_LDA(At, 0, 1); PG8_STAGE(PG8_SA(0, 0), a2, voffA);
            PG8_BAR; PG8_WAIT_L(0); PG8_MMA(1, 0, At, B0); PG8_BAR; PG8_SCHED;
            PG8_STAGE(PG8_SB(0, 1), b2 + hstep, voffB);
            PG8_WAIT_V(6); PG8_BAR; PG8_MMA(1, 1, At, B1); PG8_BAR;
            PG8_LDB(B0, 1, 0); PG8_SCHED; PG8_LDA(At, 1, 0); PG8_STAGE(PG8_SA(0, 1), a2 + hstep, voffA);
            PG8_WAIT_L(8); PG8_BAR; PG8_WAIT_L(0); PG8_MMA(0, 0, At, B0); PG8_BAR; PG8_SCHED;
            PG8_LDB(B1, 1, 1); PG8_STAGE(PG8_SB(1, 0), b3, voffB);
            PG8_BAR; PG8_WAIT_L(0); PG8_MMA(0, 1, At, B1); PG8_BAR;
            PG8_LDA(At, 1, 1); PG8_STAGE(PG8_SA(1, 0), a3, voffA);
            PG8_BAR; PG8_WAIT_L(0); PG8_MMA(1, 0, At, B0); PG8_BAR; PG8_SCHED;
            PG8_STAGE(PG8_SB(1, 1), b3 + hstep, voffB);
            PG8_WAIT_V(6); PG8_BAR; PG8_MMA(1, 1, At, B1); PG8_BAR;
            }
        }
        if constexpr (ALIGN_EPI) { if (wr == 0) PG8_BAR; }
        if constexpr (!Epi::AFTER_DRAIN) { E(acc, cur, wr, wc, fr, fq); S.done(cur); }
        if (!has_next) break;
#pragma unroll
        for (int a = 0; a < 2; ++a)
#pragma unroll
            for (int b = 0; b < 2; ++b)
#pragma unroll
                for (int m = 0; m < 4; ++m)
#pragma unroll
                    for (int n = 0; n < 2; ++n) acc[a][b][m][n] = (f32x4){0.f, 0.f, 0.f, 0.f};
        cur = nxt; cA = nA; cB = nB; ++ui;
        if constexpr (ALIGN_EPI) { if (wr == 1) PG8_BAR; }
    }
    PG8_WAIT_V(0);
    if constexpr (!ALIGN_EPI) { if (wr == 0) PG8_BAR; }
    PG8_BAR;
    if constexpr (Epi::AFTER_DRAIN) { E.fused(acc, cur, wr, wc, fr, fq, lds, wid, lane); S.done(cur); }
#undef PG8_SA
#undef PG8_SB
#undef PG8_STAGE
#undef PG8_LDA
#undef PG8_LDB
#undef PG8_MMA
#undef PG8_WAIT_V
#undef PG8_WAIT_L
#undef PG8_BAR
#undef PG8_SCHED
}
}
#define DI __device__ __forceinline__
#define LAS __attribute__((address_space(3)))
typedef unsigned short bf16;
typedef short bf16x8 __attribute__((ext_vector_type(8)));
typedef short s16x4 __attribute__((ext_vector_type(4)));
typedef float f32x4 __attribute__((ext_vector_type(4)));
typedef float f32x16 __attribute__((ext_vector_type(16)));
typedef unsigned u32x4 __attribute__((ext_vector_type(4)));
typedef unsigned u32x2 __attribute__((ext_vector_type(2)));
typedef float f32x2_t __attribute__((ext_vector_type(2)));
typedef __bf16 bf16x2_t __attribute__((ext_vector_type(2)));

constexpr int NB = 4, SEQ = 8192, DM = 1024, MT = NB * SEQ, INW = 4104;
constexpr int NTHREADS = 512;
constexpr size_t MiB = 1u << 20;
constexpr size_t WS_CTL = 0;
constexpr size_t WS_WIN = 1 * MiB;
constexpr size_t WS_WOUT = 9 * MiB;
constexpr size_t WS_PART = 11 * MiB;
constexpr size_t WS_GATE = 12 * MiB;
constexpr size_t WS_GL = 12 * MiB + 65536;
constexpr size_t WS_BETA = 13 * MiB;
constexpr size_t WS_G = 13 * MiB + 512 * 1024;
constexpr size_t WS_XN = 16 * MiB;
constexpr size_t WS_QD = 16 * MiB, WS_KD = 48 * MiB;
constexpr size_t WS_PROJ = 80 * MiB;
constexpr size_t PROJ_SUB = 32 * MiB;
constexpr size_t WS_MIXED = 80 * MiB;
constexpr size_t WS_OG = 208 * MiB;
constexpr size_t WS_SCAN = 336 * MiB;
constexpr size_t SCAN_CHUNK = 73728;
constexpr size_t WS_VT = 480 * MiB;
constexpr size_t WS_END = 512 * MiB;
constexpr int LDS_BYTES = 147456 + 64;

struct Params {
    const float* x; const float* c; const int* pos; const float* norm_g; const float* w_ada; const float* b_ada; const float* w_in;
    const float* conv_w; const float* a_log; const float* dt_bias; const float* gdn_g; const float* qn_g; const float* kn_g;
    const float* lq1; const float* lk1; const float* lq2; const float* lk2; const float* subln_g; const float* w_out;
    float* out; unsigned char* ws;
};

DI unsigned pk2(float lo, float hi) { f32x2_t v = {lo, hi}; bf16x2_t b = __builtin_convertvector(v, bf16x2_t); return __builtin_bit_cast(unsigned, b); }
DI float bflo(unsigned u) { return __uint_as_float(u << 16); }
DI float bfhi(unsigned u) { return __uint_as_float(u & 0xffff0000u); }
DI unsigned short f2bf(float f) { return (unsigned short)(pk2(f, 0.f) & 0xffffu); }
DI float wave_sum(float v) {
#pragma unroll
    for (int o = 1; o < 64; o <<= 1) v += __shfl_xor(v, o);
    return v;
}
DI float max3f(float a, float b, float c) { float r; asm("v_max3_f32 %0, %1, %2, %3" : "=v"(r) : "v"(a), "v"(b), "v"(c)); return r; }
DI int crow(int i, int h) { return (i & 3) + 8 * (i >> 2) + 4 * h; }
DI float silu_f(float v) { return v * __builtin_amdgcn_rcpf(1.f + __expf(-v)); }
#define MFMA32(a, b, c) __builtin_amdgcn_mfma_f32_32x32x16_bf16((a), (b), (c), 0, 0, 0)
template <int S> DI bf16x8 pack8(const f32x16& x) {
    u32x4 p; p.x = pk2(x[8 * S], x[8 * S + 1]); p.y = pk2(x[8 * S + 2], x[8 * S + 3]); p.z = pk2(x[8 * S + 4], x[8 * S + 5]); p.w = pk2(x[8 * S + 6], x[8 * S + 7]);
    return __builtin_bit_cast(bf16x8, p);
}
DI void unpack8(u32x4 w, float* f) { f[0] = bflo(w.x); f[1] = bfhi(w.x); f[2] = bflo(w.y); f[3] = bfhi(w.y); f[4] = bflo(w.z); f[5] = bfhi(w.z); f[6] = bflo(w.w); f[7] = bfhi(w.w); }
DI f32x16 zero16() { f32x16 z; for (int i = 0; i < 16; ++i) z[i] = 0.f; return z; }

DI void p0_transpose_item(const float* W, int K, int ldw, int nblk, bf16* WT, LAS float* scr, int item, int lane, int shift_at, int shift) {
    const int kb = item / nblk, nb = item % nblk, k0 = 64 * kb, n0 = 32 * nb, ns = n0 + (n0 >= shift_at ? shift : 0);
#pragma unroll 8
    for (int i = 0; i < 32; ++i) { const int kk = 2 * i + (lane >> 5); scr[kk * 33 + (lane & 31)] = W[(size_t)(k0 + kk) * ldw + ns + (lane & 31)]; }
    asm volatile("s_waitcnt lgkmcnt(0)" ::: "memory");
    const int c = lane & 7;
#pragma unroll
    for (int j = 0; j < 4; ++j) { const int n = (lane >> 3) + 8 * j; const LAS float* s = scr + (8 * c) * 33 + n;
        u32x4 o; o.x = pk2(s[0 * 33], s[1 * 33]); o.y = pk2(s[2 * 33], s[3 * 33]); o.z = pk2(s[4 * 33], s[5 * 33]); o.w = pk2(s[6 * 33], s[7 * 33]);
        *(u32x4*)(WT + (size_t)(n0 + n) * K + k0 + 8 * c) = o; }
    asm volatile("s_waitcnt lgkmcnt(0)" ::: "memory");
}
DI void p0_phase(const Params& p, LAS unsigned char* lds, int tid, int lane, int wave) {
    LAS float* sc = (LAS float*)lds;
    for (int i = tid; i < 4096; i += NTHREADS) sc[i] = silu_f(p.c[i]);
    __syncthreads();
    float* part = (float*)(p.ws + WS_PART);
    const int gw = blockIdx.x * 8 + wave, NGW = gridDim.x * 8;
    for (int it = gw; it < 768; it += NGW) {
        {
            const int kp = it / 48, cgp = it % 48, j = cgp * 64 + lane;
            float a0 = 0.f, a1 = 0.f, a2 = 0.f, a3 = 0.f;
            const float* w = p.w_ada + (size_t)(kp * 64) * 3072 + j;
#pragma unroll 8
            for (int k = 0; k < 64; ++k) { const float wv = w[(size_t)k * 3072]; const int kk = kp * 64 + k;
                a0 += sc[kk] * wv; a1 += sc[1024 + kk] * wv; a2 += sc[2048 + kk] * wv; a3 += sc[3072 + kk] * wv; }
            part[(size_t)(kp * 4 + 0) * 3072 + j] = a0; part[(size_t)(kp * 4 + 1) * 3072 + j] = a1;
            part[(size_t)(kp * 4 + 2) * 3072 + j] = a2; part[(size_t)(kp * 4 + 3) * 3072 + j] = a3;
        }
    }
    if (blockIdx.x == 0) for (int i = tid; i < 1024; i += NTHREADS) ((unsigned*)(p.ws + WS_CTL))[i] = 0u;
}

DI void p1_phase(const Params& p, LAS unsigned char* lds, int tid, int lane, int wave) {
    LAS float* Ak = (LAS float*)lds; LAS float* Bk = Ak + 1024; LAS float* W8 = Bk + 1024;
    const float* part = (const float*)(p.ws + WS_PART);
    float* gate = (float*)(p.ws + WS_GATE);
    bf16* XN = (bf16*)(p.ws + WS_XN);
    float* BETA = (float*)(p.ws + WS_BETA); float* GG = (float*)(p.ws + WS_G);
    for (int i = tid; i < 8192; i += NTHREADS) W8[(i & 7) * 1024 + (i >> 3)] = p.w_in[(size_t)(i >> 3) * INW + 1536 + (i & 7)];
    {
        LAS float* scr = (LAS float*)(lds + 40960 + wave * 8704);
        const int gw = blockIdx.x * 8 + wave, NGW = gridDim.x * 8;
        for (int it = gw; it < 2048 + 512; it += NGW) {
            if (it < 2048) p0_transpose_item(p.w_in, 1024, INW, 128, (bf16*)(p.ws + WS_WIN), scr, it, lane, 1536, 8);
            else p0_transpose_item(p.w_out, 1024, 1024, 32, (bf16*)(p.ws + WS_WOUT), scr, it - 2048, lane, 1 << 30, 0);
        }
    }
    for (int rb = blockIdx.x; rb < 256; rb += gridDim.x) {
        const int b = rb >> 6;
        __syncthreads();
        for (int k = tid; k < 1024; k += NTHREADS) {
            float sh = p.b_ada[k], scl = p.b_ada[1024 + k];
            for (int kp = 0; kp < 16; ++kp) { sh += part[(size_t)(kp * 4 + b) * 3072 + k]; scl += part[(size_t)(kp * 4 + b) * 3072 + 1024 + k]; }
            Ak[k] = p.norm_g[k] * (1.f + scl); Bk[k] = sh;
            if ((rb & 63) == 0) { float g = p.b_ada[2048 + k]; for (int kp = 0; kp < 16; ++kp) g += part[(size_t)(kp * 4 + b) * 3072 + 2048 + k]; gate[b * 1024 + k] = g; }
        }
        __syncthreads();
        for (int i = 0; i < 16; ++i) {
            const int m = rb * 128 + wave * 16 + i;
            const f32x4* xr = (const f32x4*)(p.x + (size_t)m * DM) + lane;
            f32x4 v[4]; float ss = 0.f;
#pragma unroll
            for (int j = 0; j < 4; ++j) { v[j] = xr[64 * j]; ss += (v[j].x * v[j].x + v[j].y * v[j].y) + (v[j].z * v[j].z + v[j].w * v[j].w); }
            const float rstd = rsqrtf(wave_sum(ss) * (1.f / 1024.f) + 1e-6f);
            float d8[8];
#pragma unroll
            for (int cidx = 0; cidx < 8; ++cidx) d8[cidx] = 0.f;
#pragma unroll
            for (int j = 0; j < 4; ++j) {
                const int k0 = 4 * lane + 256 * j; float hv[4];
                const f32x4 av = *(const LAS f32x4*)(Ak + k0), bv = *(const LAS f32x4*)(Bk + k0);
#pragma unroll
                for (int e = 0; e < 4; ++e) hv[e] = v[j][e] * rstd * av[e] + bv[e];
#pragma unroll
                for (int cidx = 0; cidx < 8; ++cidx) { const f32x4 wv = *(const LAS f32x4*)(W8 + cidx * 1024 + k0);
                    d8[cidx] += (hv[0] * wv.x + hv[1] * wv.y) + (hv[2] * wv.z + hv[3] * wv.w); }
                u32x2 o; o.x = pk2(hv[0], hv[1]); o.y = pk2(hv[2], hv[3]);
                *(u32x2*)(XN + (size_t)m * DM + k0) = o;
                asm volatile("" ::: "memory");
            }
            float mine = 0.f;
#pragma unroll
            for (int cidx = 0; cidx < 8; ++cidx) { const float t = wave_sum(d8[cidx]); mine = ((lane & 7) == cidx) ? t : mine; }
            if (lane < 4) BETA[(size_t)m * 4 + lane] = 1.f / (1.f + __expf(-mine));
            else if (lane < 8) { const int hh = lane - 4; const float z = mine + p.dt_bias[hh];
                const float sp = fmaxf(z, 0.f) + log1pf(__expf(-fabsf(z)));
                GG[(size_t)m * 4 + hh] = -__expf(p.a_log[hh]) * sp; }
        }
    }
}

constexpr int P3_QS = 0, P3_KS = 17408, P3_KT = 34816, P3_VBT = 72192, P3_MS = 109568, P3_TS = 126976, P3_SM = 136192;
DI int tro(int row) { return row * 144 + ((row >> 3) << 4); }
#define P3_COMMON \
    const int bh = item >> 7, n = item & 127, b = bh >> 2, hd = bh & 3; \
    const size_t m0 = (size_t)b * SEQ + (size_t)n * 64; \
    const int KTo = P3_KT + pb * 18688, VBo = P3_VBT + pb * 18688; \
    LAS float* GC = (LAS float*)(lds + P3_SM + pb * 1280); LAS float* BE = GC + 64; LAS float* EG = GC + 128; LAS float* KDS = GC + 192; LAS float* BG = GC + 256; \
    const float* BETA = (const float*)(p.ws + WS_BETA); const float* GG = (const float*)(p.ws + WS_G); \
    unsigned char* cb = p.ws + WS_SCAN + (size_t)item * SCAN_CHUNK; \
    const int r = lane & 31, h = lane >> 5; \
    (void)b; (void)hd; (void)m0; (void)KTo; (void)VBo; (void)GC; (void)BE; (void)EG; (void)KDS; (void)BG; (void)BETA; (void)GG; (void)cb; (void)r; (void)h; (void)n;

DI void gdn_s1(const Params& p, LAS unsigned char* lds, int item, int pb, int tid, int lane, int wave) {
    asm volatile("" : "+v"(tid), "+v"(lane));
    P3_COMMON
    if (wave == 1) {
        float g = GG[(m0 + lane) * 4 + hd];
#pragma unroll
        for (int o = 1; o < 64; o <<= 1) { const float t = __shfl_up(g, o); if (lane >= o) g += t; }
        const float glast = __shfl(g, 63);
        const float be = BETA[(m0 + lane) * 4 + hd];
        GC[lane] = g; BE[lane] = be; const float eg = __expf(g); EG[lane] = eg; KDS[lane] = __expf(glast - g); BG[lane] = be * eg;
        if (lane == 63) ((float*)(p.ws + WS_GL))[item] = eg;
    }
    const int t7 = tid - 64;
    u32x4 raw[7][4];
#pragma unroll
    for (int k = 0; k < 7; ++k) {
        const int u = t7 + 448 * k, which = u >> 10, tt = (u & 1023) >> 4, ch0 = (u & 15) * 8, tpos = n * 64 + tt;
        const bf16* X = (const bf16*)(p.ws + WS_PROJ + (size_t)(which < 3 ? which : 0) * PROJ_SUB);
#pragma unroll
        for (int j = 0; j < 4; ++j) {
            raw[k][j] = (u32x4){0u, 0u, 0u, 0u};
            if (u < 3072 && tpos - 3 + j >= 0) raw[k][j] = *(const u32x4*)(X + (m0 + tt - 3 + j) * 512 + hd * 128 + ch0);
        }
    }
#pragma unroll
    for (int k = 0; k < 7; ++k) {
        const int u = t7 + 448 * k, which = __builtin_amdgcn_readfirstlane(u >> 10), tt = (u & 1023) >> 4, ch0 = (u & 15) * 8;
        const bool valid = u < 3072;
        const int cbase = (which < 3 ? which : 0) * 512 + hd * 128 + ch0;
        float cw[4][8];
#pragma unroll
        for (int j = 0; j < 4; ++j) { const f32x4 a = *(const f32x4*)(p.conv_w + (size_t)j * 1536 + cbase), c2 = *(const f32x4*)(p.conv_w + (size_t)j * 1536 + cbase + 4);
            cw[j][0] = a.x; cw[j][1] = a.y; cw[j][2] = a.z; cw[j][3] = a.w; cw[j][4] = c2.x; cw[j][5] = c2.y; cw[j][6] = c2.z; cw[j][7] = c2.w; }
        float acc[8];
#pragma unroll
        for (int e = 0; e < 8; ++e) acc[e] = 0.f;
#pragma unroll
        for (int j = 0; j < 4; ++j) {
            float f[8]; unpack8(raw[k][j], f);
#pragma unroll
            for (int e = 0; e < 8; ++e) acc[e] += cw[j][e] * f[e];
        }
#pragma unroll
        for (int e = 0; e < 8; ++e) acc[e] = silu_f(acc[e]);
        if (which < 2) {
            float ss = 0.f;
#pragma unroll
            for (int e = 0; e < 8; ++e) ss += acc[e] * acc[e];
            ss += __shfl_xor(ss, 1); ss += __shfl_xor(ss, 2); ss += __shfl_xor(ss, 4); ss += __shfl_xor(ss, 8);
            const float inv = rsqrtf(ss + 1e-6f) * (which == 0 ? 0.08838834764831845f : 1.f);
#pragma unroll
            for (int e = 0; e < 8; ++e) acc[e] *= inv;
            u32x4 o; o.x = pk2(acc[0], acc[1]); o.y = pk2(acc[2], acc[3]); o.z = pk2(acc[4], acc[5]); o.w = pk2(acc[6], acc[7]);
            *(LAS u32x4*)(lds + (which == 0 ? P3_QS : P3_KS) + tt * 272 + ch0 * 2) = o;
            if (which == 1) {
#pragma unroll
                for (int e = 0; e < 8; ++e) *(LAS unsigned short*)(lds + KTo + tro(ch0 + e) + tt * 2) = f2bf(acc[e]);
            }
        } else if (valid) {
            const float be = BETA[(m0 + tt) * 4 + hd];
#pragma unroll
            for (int e = 0; e < 8; ++e) *(LAS unsigned short*)(lds + VBo + tro(ch0 + e) + tt * 2) = f2bf(acc[e] * be);
        }
    }
}
DI void gdn_s2(const Params& p, LAS unsigned char* lds, int item, int pb, int tid, int lane, int wave) {
    asm volatile("" : "+v"(tid), "+v"(lane));
    P3_COMMON
    {
        const int w4 = wave & 3, R = w4 >> 1, C = w4 & 1;
        const bool isG = wave < 4;
        f32x16 acc = zero16();
        const bool zero_tile = isG ? (R == 0 && C == 1) : (R == 1 && C == 0);
        if (!zero_tile) {
            bf16x8 fa[8], fb[8];
            const LAS unsigned char* Ab = lds + P3_KS + (32 * R + r) * 272 + h * 16;
            const LAS unsigned char* Bb = lds + (isG ? P3_KS : P3_QS) + (32 * C + r) * 272 + h * 16;
#pragma unroll
            for (int s = 0; s < 8; ++s) { fa[s] = *(const LAS bf16x8*)(Ab + s * 32); fb[s] = *(const LAS bf16x8*)(Bb + s * 32); }
            __builtin_amdgcn_sched_barrier(0);
#pragma unroll
            for (int s = 0; s < 8; ++s) acc = MFMA32(fa[s], fb[s], acc);
        }
        const int col = 32 * C + r; const float gcc = GC[col];
        float gcr[16], ber[16];
#pragma unroll
        for (int g4 = 0; g4 < 4; ++g4) { const f32x4 gv = *(const LAS f32x4*)(GC + 32 * R + 8 * g4 + 4 * h), bv = *(const LAS f32x4*)(BE + 32 * R + 8 * g4 + 4 * h);
            gcr[4 * g4] = gv.x; gcr[4 * g4 + 1] = gv.y; gcr[4 * g4 + 2] = gv.z; gcr[4 * g4 + 3] = gv.w; ber[4 * g4] = bv.x; ber[4 * g4 + 1] = bv.y; ber[4 * g4 + 2] = bv.z; ber[4 * g4 + 3] = bv.w; }
        if (isG) {
#pragma unroll
            for (int i = 0; i < 16; ++i) { const int row = 32 * R + crow(i, h);
                const float e = __expf(fminf(gcr[i] - gcc, 0.f));
                const float v = ber[i] * acc[i] * e;
                *(LAS float*)(lds + P3_MS + row * 272 + col * 4) = (col < row) ? v : 0.f; }
        } else {
            f32x16 o;
#pragma unroll
            for (int i = 0; i < 16; ++i) { const int row = 32 * R + crow(i, h);
                const float e = __expf(fminf(gcc - gcr[i], 0.f));
                const float v = acc[i] * e;
                o[i] = (row <= col) ? v : 0.f; }
            unsigned char* at = cb + 49152;
            *(bf16x8*)(at + ((size_t)(C * 4 + 2 * R + 0) * 64 + lane) * 16) = pack8<0>(o);
            *(bf16x8*)(at + ((size_t)(C * 4 + 2 * R + 1) * 64 + lane) * 16) = pack8<1>(o);
        }
    }
        for (int f = wave; f < 32; f += 8) {
            if (f < 16) {
                const int Rc = f >> 3, s = f & 7, cc = 32 * Rc + r;
                const u32x2 lo = *(const LAS u32x2*)(lds + P3_QS + cc * 272 + (16 * s + 4 * h) * 2), hi = *(const LAS u32x2*)(lds + P3_QS + cc * 272 + (16 * s + 8 + 4 * h) * 2);
                const float eg = EG[cc];
                u32x4 o; o.x = pk2(bflo(lo.x) * eg, bfhi(lo.x) * eg); o.y = pk2(bflo(lo.y) * eg, bfhi(lo.y) * eg); o.z = pk2(bflo(hi.x) * eg, bfhi(hi.x) * eg); o.w = pk2(bflo(hi.y) * eg, bfhi(hi.y) * eg);
                *(u32x4*)(cb + 16384 + ((size_t)f * 64 + lane) * 16) = o;
            } else {
                const int f2 = f - 16, Rd = f2 >> 2, s = f2 & 3, dk = 32 * Rd + r, c0 = 16 * s + 4 * h;
                const u32x2 lo = *(const LAS u32x2*)(lds + KTo + tro(dk) + c0 * 2), hi = *(const LAS u32x2*)(lds + KTo + tro(dk) + (c0 + 8) * 2);
                const f32x4 k0v = *(const LAS f32x4*)(KDS + c0), k1v = *(const LAS f32x4*)(KDS + c0 + 8);
                u32x4 o; o.x = pk2(bflo(lo.x) * k0v.x, bfhi(lo.x) * k0v.y); o.y = pk2(bflo(lo.y) * k0v.z, bfhi(lo.y) * k0v.w);
                o.z = pk2(bflo(hi.x) * k1v.x, bfhi(hi.x) * k1v.y); o.w = pk2(bflo(hi.y) * k1v.z, bfhi(hi.y) * k1v.w);
                *(u32x4*)(cb + 32768 + ((size_t)f2 * 64 + lane) * 16) = o;
            }
        }
}
DI void gdn_solve(LAS unsigned char* lds, int lane) {
    asm volatile("" : "+v"(lane));
    {
        f32x2_t tp[32]; const float lanef = (float)lane;
        int vz = 0; asm volatile("" : "+v"(vz));
        const LAS unsigned char* msb = lds + P3_MS + vz;
        f32x4 mcur[16], mnxt[16];
#pragma unroll
        for (int j4 = 0; j4 < 16; ++j4) { mcur[j4] = (f32x4){0.f, 0.f, 0.f, 0.f}; mnxt[j4] = mcur[j4]; }
#pragma unroll
        for (int i = 0; i < 64; ++i) {
            if (i + 1 < 64) {
#pragma unroll
                for (int j4 = 0; j4 < (i + 1 + 3) / 4; ++j4) mnxt[j4] = *(const LAS f32x4*)(msb + (i + 1) * 272 + j4 * 16);
            }
            __builtin_amdgcn_sched_barrier(0);
            f32x2_t acc2 = {0.f, 0.f}, acc3 = {0.f, 0.f}, acc4 = {0.f, 0.f}, acc5 = {0.f, 0.f};
#pragma unroll
            for (int j4 = 0; j4 < (i + 3) / 4; ++j4) {
                const f32x4 mv = mcur[j4];
                if (j4 & 1) {
                    if (4 * j4 + 1 < i) acc4 += (f32x2_t){mv.x, mv.y} * tp[2 * j4];
                    else if (4 * j4 + 0 < i) acc4.x += mv.x * tp[2 * j4].x;
                    if (4 * j4 + 3 < i) acc5 += (f32x2_t){mv.z, mv.w} * tp[2 * j4 + 1];
                    else if (4 * j4 + 2 < i) acc5.x += mv.z * tp[2 * j4 + 1].x;
                } else {
                    if (4 * j4 + 1 < i) acc2 += (f32x2_t){mv.x, mv.y} * tp[2 * j4];
                    else if (4 * j4 + 0 < i) acc2.x += mv.x * tp[2 * j4].x;
                    if (4 * j4 + 3 < i) acc3 += (f32x2_t){mv.z, mv.w} * tp[2 * j4 + 1];
                    else if (4 * j4 + 2 < i) acc3.x += mv.z * tp[2 * j4 + 1].x;
                }
            }
            acc2 = (acc2 + acc3) + (acc4 + acc5);
            const float a = fmaxf(0.f, 1.f - fabsf(lanef - (float)i)) - (acc2.x + acc2.y);
            if (i & 1) tp[i >> 1].y = a; else tp[i >> 1].x = a;
            *(LAS unsigned short*)(lds + P3_TS + i * 144 + lane * 2) = f2bf(a);
            __builtin_amdgcn_sched_barrier(0);
#pragma unroll
            for (int j4 = 0; j4 < 16; ++j4) mcur[j4] = mnxt[j4];
        }
    }
}
DI void gdn_s4(const Params& p, LAS unsigned char* lds, int item, int pb, int tid, int lane, int wave) {
    asm volatile("" : "+v"(tid), "+v"(lane));
    P3_COMMON
    {
        const int Rd = wave >> 1, Cc = wave & 1, Rc = wave >> 2, Cv = wave & 3;
        u32x4 kr[4]; f32x4 b0[4], b1[4]; bf16x8 tb[4], ta[4], vb[4];
#pragma unroll
        for (int s = 0; s < 4; ++s) {
            kr[s] = *(const LAS u32x4*)(lds + KTo + tro(32 * Rd + r) + (16 * s + 8 * h) * 2);
            b0[s] = *(const LAS f32x4*)(BG + 16 * s + 8 * h); b1[s] = *(const LAS f32x4*)(BG + 16 * s + 8 * h + 4);
            tb[s] = *(const LAS bf16x8*)(lds + P3_TS + (32 * Cc + r) * 144 + (16 * s + 8 * h) * 2);
            ta[s] = *(const LAS bf16x8*)(lds + P3_TS + (32 * Rc + r) * 144 + (16 * s + 8 * h) * 2);
            vb[s] = *(const LAS bf16x8*)(lds + VBo + tro(32 * Cv + r) + (16 * s + 8 * h) * 2);
        }
        __builtin_amdgcn_sched_barrier(0);
        f32x16 ua = zero16();
#pragma unroll
        for (int s = 0; s < 4; ++s) ua = MFMA32(ta[s], vb[s], ua);
        f32x16 acc = zero16();
#pragma unroll
        for (int s = 0; s < 4; ++s) {
            u32x4 ka; ka.x = pk2(bflo(kr[s].x) * b0[s].x, bfhi(kr[s].x) * b0[s].y); ka.y = pk2(bflo(kr[s].y) * b0[s].z, bfhi(kr[s].y) * b0[s].w);
            ka.z = pk2(bflo(kr[s].z) * b1[s].x, bfhi(kr[s].z) * b1[s].y); ka.w = pk2(bflo(kr[s].w) * b1[s].z, bfhi(kr[s].w) * b1[s].w);
            acc = MFMA32(__builtin_bit_cast(bf16x8, ka), tb[s], acc);
        }
#pragma unroll
        for (int i = 0; i < 16; ++i) acc[i] = -acc[i];
        *(bf16x8*)(cb + ((size_t)(Cc * 8 + 2 * Rd + 0) * 64 + lane) * 16) = pack8<0>(acc);
        *(bf16x8*)(cb + ((size_t)(Cc * 8 + 2 * Rd + 1) * 64 + lane) * 16) = pack8<1>(acc);
        unsigned char* up = cb + 57344 + ((size_t)(Rc * 4 + Cv) * 64 + lane) * 32;
        *(bf16x8*)(up) = pack8<0>(ua); *(bf16x8*)(up + 16) = pack8<1>(ua);
    }
}
DI void gdn_prep_all(const Params& p, LAS unsigned char* lds, int tid, int lane, int wave, const int abl = 0) {
    const int G = (int)gridDim.x, first = (int)blockIdx.x;
    if (first >= 2048) return;
    if (wave >= 1) gdn_s1(p, lds, first, 0, tid, lane, wave);
    __syncthreads();
    gdn_s2(p, lds, first, 0, tid, lane, wave);
    __syncthreads();
    int pb = 0;
    for (int it = first; it < 2048; it += G, pb ^= 1) {
        const int nx = it + G;
        if (wave == 0) { if (abl != 5) gdn_solve(lds, lane); }
        else if (nx < 2048 && abl != 6) gdn_s1(p, lds, nx, pb ^ 1, tid, lane, wave);
        __syncthreads();
        gdn_s4(p, lds, it, pb, tid, lane, wave);
        if (nx < 2048) gdn_s2(p, lds, nx, pb ^ 1, tid, lane, wave);
        __syncthreads();
    }
}

DI void diff_prep_item(const Params& p, LAS unsigned char* lds, int item, int tid, int lane, int wave) {
    asm volatile("" : "+v"(tid), "+v"(lane));
    const int bh = item >> 7, n = item & 127, b = bh >> 2, hd = bh & 3;
    const size_t m0 = (size_t)b * SEQ + (size_t)n * 64;
    const int tt = tid >> 3, part = tid & 7, d0 = part * 8;
    LAS float* CS = (LAS float*)(lds + 32768); LAS float* SN = CS + 512;
    u32x4 rawqk[2][2], rawv[2];
#pragma unroll
    for (int which = 0; which < 2; ++which)
#pragma unroll
        for (int sub = 0; sub < 2; ++sub) rawqk[which][sub] = *(const u32x4*)((const bf16*)(p.ws + WS_PROJ + (size_t)(4 + which) * PROJ_SUB) + (m0 + tt) * 512 + hd * 128 + sub * 64 + d0);
#pragma unroll
    for (int i = 0; i < 2; ++i) { const int pc = tid + 512 * i, tk = pc >> 4, dv0 = (pc & 15) * 8;
        rawv[i] = *(const u32x4*)((const bf16*)(p.ws + WS_PROJ + (size_t)6 * PROJ_SUB) + (m0 + tk) * 512 + hd * 128 + dv0); }
    {
        const float invf = exp2f(-(float)part * (18.931568569324174f / 8.f));
        const float ang = (float)p.pos[m0 + tt] * invf;
        double xr = (double)ang * 0.15915494309189535; xr -= __builtin_rint(xr);
        const float fr = (float)xr;
        CS[tid] = __builtin_amdgcn_cosf(fr); SN[tid] = __builtin_amdgcn_sinf(fr);
    }
    __syncthreads();
#pragma unroll
    for (int which = 0; which < 2; ++which) {
        const float* gn = which ? p.kn_g : p.qn_g;
        bf16* dst = (bf16*)(p.ws + (which ? WS_KD : WS_QD));
#pragma unroll
        for (int sub = 0; sub < 2; ++sub) {
            float y[8]; unpack8(rawqk[which][sub], y);
            float ss = 0.f;
#pragma unroll
            for (int e = 0; e < 8; ++e) ss += y[e] * y[e];
            ss += __shfl_xor(ss, 1); ss += __shfl_xor(ss, 2); ss += __shfl_xor(ss, 4);
            const float rstd = rsqrtf(ss * (1.f / 64.f) + 1e-6f);
#pragma unroll
            for (int e = 0; e < 8; ++e) y[e] = y[e] * rstd * gn[d0 + e];
            float oth[8];
#pragma unroll
            for (int e = 0; e < 8; ++e) oth[e] = __shfl_xor(y[e], 1);
            if (part < 2) {
#pragma unroll
                for (int e = 0; e < 8; ++e) {
                    const float cs = CS[tt * 8 + e], sn = SN[tt * 8 + e];
                    y[e] = (part == 0) ? (y[e] * cs - oth[e] * sn) : (y[e] * cs + oth[e] * sn);
                }
            }
            const float qs = which ? 1.f : 0.125f * 1.4426950408889634f;
            u32x4 o; o.x = pk2(y[0] * qs, y[1] * qs); o.y = pk2(y[2] * qs, y[3] * qs); o.z = pk2(y[4] * qs, y[5] * qs); o.w = pk2(y[6] * qs, y[7] * qs);
            *(u32x4*)(dst + ((size_t)(bh * 2 + sub) * SEQ + (size_t)n * 64 + tt) * 64 + d0) = o;
        }
    }
#pragma unroll
    for (int i = 0; i < 2; ++i) { const int pc = tid + 512 * i, tk = pc >> 4, dv0 = (pc & 15) * 8;
        const unsigned w4[4] = {rawv[i].x, rawv[i].y, rawv[i].z, rawv[i].w};
#pragma unroll
        for (int e = 0; e < 8; ++e) *(LAS unsigned short*)(lds + tro(dv0 + e) + tk * 2) = (unsigned short)((e & 1) ? (w4[e >> 1] >> 16) : (w4[e >> 1] & 0xffffu)); }
    __syncthreads();
    bf16* VT = (bf16*)(p.ws + WS_VT);
#pragma unroll
    for (int i = 0; i < 2; ++i) { const int pc = tid + 512 * i, dv = pc >> 3, tk0 = (pc & 7) * 8;
        const u32x4 v = *(const LAS u32x4*)(lds + tro(dv) + tk0 * 2);
        *(u32x4*)(VT + ((size_t)bh * 128 + dv) * SEQ + (size_t)n * 64 + tk0) = v; }
    __syncthreads();
}

constexpr int SC_BUF = 57344, SC_OB = 114688;
DI void scan_post(const Params& p, LAS unsigned char* lds, int bh, int n, int pt) {
    const int b = bh >> 2, hd = bh & 3, row = pt >> 2, q = pt & 3;
    const size_t m = (size_t)b * SEQ + (size_t)n * 64 + row;
    const bf16* AG = (const bf16*)(p.ws + WS_PROJ + (size_t)3 * PROJ_SUB) + m * 512 + hd * 128 + q * 32;
    u32x4 gv[4], ov[4];
#pragma unroll
    for (int j = 0; j < 4; ++j) gv[j] = *(const u32x4*)(AG + j * 8);
#pragma unroll
    for (int j = 0; j < 4; ++j) ov[j] = *(const LAS u32x4*)(lds + SC_OB + (n & 1) * 16384 + row * 256 + q * 64 + j * 16);
    float o[32], g[32];
#pragma unroll
    for (int j = 0; j < 4; ++j) { unpack8(ov[j], o + 8 * j); unpack8(gv[j], g + 8 * j); }
    float ss = 0.f;
#pragma unroll
    for (int j = 0; j < 32; ++j) ss += o[j] * o[j];
    ss += __shfl_xor(ss, 1); ss += __shfl_xor(ss, 2);
    const float rstd = rsqrtf(ss * (1.f / 128.f) + 1e-6f);
    bf16* MX = (bf16*)(p.ws + WS_MIXED) + m * 1024 + hd * 128 + q * 32;
#pragma unroll
    for (int j = 0; j < 4; ++j) {
        const f32x4 w0 = *(const f32x4*)(p.gdn_g + q * 32 + j * 8), w1 = *(const f32x4*)(p.gdn_g + q * 32 + j * 8 + 4);
        const float wg[8] = {w0.x, w0.y, w0.z, w0.w, w1.x, w1.y, w1.z, w1.w};
        float y[8];
#pragma unroll
        for (int e = 0; e < 8; ++e) y[e] = o[8 * j + e] * rstd * wg[e] * silu_f(g[8 * j + e]);
        u32x4 w; w.x = pk2(y[0], y[1]); w.y = pk2(y[2], y[3]); w.z = pk2(y[4], y[5]); w.w = pk2(y[6], y[7]);
        *(u32x4*)(MX + j * 8) = w;
    }
}
DI void scan_job(const Params& p, LAS unsigned char* lds, int bh, int tid, int lane, int wave) {
    asm volatile("" : "+v"(tid), "+v"(lane));
    const int r = lane & 31, h = lane >> 5;
    const unsigned char* gsrc = p.ws + WS_SCAN + (size_t)(bh * 128) * SCAN_CHUNK;
    if (wave >= 4) {
        const int pt = tid - 256;
        u32x4 pr[14];
#pragma unroll
        for (int i = 0; i < 14; ++i) pr[i] = *(const u32x4*)(gsrc + (size_t)(pt + 256 * i) * 16);
#pragma unroll
        for (int i = 0; i < 14; ++i) *(LAS u32x4*)(lds + (pt + 256 * i) * 16) = pr[i];
#pragma unroll
        for (int i = 0; i < 14; ++i) pr[i] = *(const u32x4*)(gsrc + SCAN_CHUNK + (size_t)(pt + 256 * i) * 16);
        __syncthreads();
#pragma unroll 1
        for (int n = 0; n < 128; ++n) {
            if (n + 1 < 128) {
                const int nb = ((n + 1) & 1) * SC_BUF;
#pragma unroll
                for (int i = 0; i < 14; ++i) *(LAS u32x4*)(lds + nb + (pt + 256 * i) * 16) = pr[i];
                if (n + 2 < 128) {
#pragma unroll
                    for (int i = 0; i < 14; ++i) pr[i] = *(const u32x4*)(gsrc + (size_t)(n + 2) * SCAN_CHUNK + (size_t)(pt + 256 * i) * 16);
                }
            }
            if (n >= 1) scan_post(p, lds, bh, n - 1, pt);
            __syncthreads();
        }
        scan_post(p, lds, bh, 127, pt);
    } else {
        const int sl = wave;
        f32x16 S[4];
#pragma unroll
        for (int i = 0; i < 4; ++i) S[i] = zero16();
        const float* GL = (const float*)(p.ws + WS_GL) + bh * 128;
        float gl_next = GL[0];
        u32x4 ucur[2][2], unxt[2][2];
#pragma unroll
        for (int Rc = 0; Rc < 2; ++Rc) { const unsigned char* up = gsrc + 57344 + ((size_t)(Rc * 4 + sl) * 64 + lane) * 32; ucur[Rc][0] = *(const u32x4*)up; ucur[Rc][1] = *(const u32x4*)(up + 16); unxt[Rc][0] = ucur[Rc][0]; unxt[Rc][1] = ucur[Rc][1]; }
        __syncthreads();
#pragma unroll 1
        for (int n = 0; n < 128; ++n) {
            const LAS unsigned char* cb = lds + (n & 1) * SC_BUF + lane * 16;
            const float gl = gl_next;
            if (n + 1 < 128) {
                gl_next = GL[n + 1];
#pragma unroll
                for (int Rc = 0; Rc < 2; ++Rc) { const unsigned char* up = gsrc + (size_t)(n + 1) * SCAN_CHUNK + 57344 + ((size_t)(Rc * 4 + sl) * 64 + lane) * 32; unxt[Rc][0] = *(const u32x4*)up; unxt[Rc][1] = *(const u32x4*)(up + 16); }
            }
            f32x16 va[2], oa[2];
#pragma unroll
            for (int Rc = 0; Rc < 2; ++Rc) {
                float f[16]; unpack8(ucur[Rc][0], f); unpack8(ucur[Rc][1], f + 8);
#pragma unroll
                for (int i = 0; i < 16; ++i) va[Rc][i] = f[i];
                oa[Rc] = zero16();
            }
#pragma unroll
            for (int s = 0; s < 8; ++s) {
                const bf16x8 sb = (s & 1) ? pack8<1>(S[s >> 1]) : pack8<0>(S[s >> 1]);
                const bf16x8 w0 = *(const LAS bf16x8*)(cb + (0 * 8 + s) * 1024), w1 = *(const LAS bf16x8*)(cb + (1 * 8 + s) * 1024);
                const bf16x8 q0 = *(const LAS bf16x8*)(cb + 16384 + (0 * 8 + s) * 1024), q1 = *(const LAS bf16x8*)(cb + 16384 + (1 * 8 + s) * 1024);
                va[0] = MFMA32(w0, sb, va[0]); va[1] = MFMA32(w1, sb, va[1]); oa[0] = MFMA32(q0, sb, oa[0]); oa[1] = MFMA32(q1, sb, oa[1]);
            }
            bf16x8 vB[4];
            vB[0] = pack8<0>(va[0]); vB[1] = pack8<1>(va[0]); vB[2] = pack8<0>(va[1]); vB[3] = pack8<1>(va[1]);
            LAS unsigned char* ob = lds + SC_OB + (n & 1) * 16384 + (sl * 32 + r) * 2;
#pragma unroll
            for (int Rc = 0; Rc < 2; ++Rc) {
#pragma unroll
                for (int ks = 0; ks < 4; ++ks) { const bf16x8 af = *(const LAS bf16x8*)(cb + 49152 + (Rc * 4 + ks) * 1024); oa[Rc] = MFMA32(af, vB[ks], oa[Rc]); }
#pragma unroll
                for (int i = 0; i < 16; ++i) *(LAS unsigned short*)(ob + (32 * Rc + crow(i, h)) * 256) = f2bf(oa[Rc][i]);
            }
#pragma unroll
            for (int Rd = 0; Rd < 4; ++Rd) {
#pragma unroll
                for (int i = 0; i < 16; ++i) S[Rd][i] *= gl;
#pragma unroll
                for (int ks = 0; ks < 4; ++ks) { const bf16x8 kf = *(const LAS bf16x8*)(cb + 32768 + (Rd * 4 + ks) * 1024); S[Rd] = MFMA32(kf, vB[ks], S[Rd]); }
            }
#pragma unroll
            for (int Rc = 0; Rc < 2; ++Rc) { ucur[Rc][0] = unxt[Rc][0]; ucur[Rc][1] = unxt[Rc][1]; }
            __syncthreads();
        }
    }
}

constexpr int AT_STAGE = 35840, AT_K1 = 9216, AT_V = 18432, AT_X = 0, AT_OST = 71680, AT_QSLOT = 147456;
DI void attn_unit(const Params& p, LAS unsigned char* lds, int bh, int qb, float lam, int tid, int lane, int wave) {
    asm volatile("" : "+v"(tid), "+v"(lane));
    const int r = lane & 31, h = lane >> 5, b = bh >> 2, hd = bh & 3;
    const int sub = wave & 1, qg = wave >> 1;
    const int q0 = qb * 128, NT = 2 * qb + 2, my_nt = 2 * qb + (qg >> 1) + 1;
    const bf16* Qd = (const bf16*)(p.ws + WS_QD); const bf16* Kd = (const bf16*)(p.ws + WS_KD); const bf16* VT = (const bf16*)(p.ws + WS_VT);
    bf16x8 qf[4];
#pragma unroll
    for (int s = 0; s < 4; ++s) qf[s] = *(const bf16x8*)(Qd + ((size_t)(bh * 2 + sub) * SEQ + q0 + 32 * qg + r) * 64 + 16 * s + 8 * h);
    const bf16* ksrc[2]; int kdst[2]; const bf16* vsrc[2]; int vdst[2];
#pragma unroll
    for (int i = 0; i < 2; ++i) { const int pc = tid + 512 * i; const int ksub = pc >> 9, key = (pc >> 3) & 63, ch = pc & 7;
        ksrc[i] = Kd + ((size_t)(bh * 2 + ksub) * SEQ + key) * 64 + ch * 8; kdst[i] = ksub * AT_K1 + key * 144 + ch * 16;
        const int dv = pc >> 3, c16 = pc & 7;
        vsrc[i] = VT + ((size_t)bh * 128 + dv) * SEQ + c16 * 8; vdst[i] = AT_V + dv * 136 + c16 * 16; }
    u32x4 kreg[2], vreg[2], kreg2[2], vreg2[2];
#pragma unroll
    for (int i = 0; i < 2; ++i) { kreg[i] = *(const u32x4*)(ksrc[i]); vreg[i] = *(const u32x4*)(vsrc[i]); }
#pragma unroll
    for (int i = 0; i < 2; ++i) { *(LAS u32x4*)(lds + kdst[i]) = kreg[i];
        *(LAS u32x2*)(lds + vdst[i]) = (u32x2){vreg[i].x, vreg[i].y}; *(LAS u32x2*)(lds + vdst[i] + 8) = (u32x2){vreg[i].z, vreg[i].w}; }
#pragma unroll
    for (int i = 0; i < 2; ++i) { kreg[i] = *(const u32x4*)(ksrc[i] + (size_t)64 * 64); vreg[i] = *(const u32x4*)(vsrc[i] + (size_t)64); }
    __syncthreads();
    f32x16 O[4];
#pragma unroll
    for (int c = 0; c < 4; ++c) O[c] = zero16();
    float mref = 0.f, lrun = 0.f;
#define AT_COMPUTE(kt, cur) do { \
        if ((kt) < my_nt) { \
            f32x16 p0, p1; \
            const LAS unsigned char* kb = lds + (cur) + sub * AT_K1 + r * 144 + h * 16; \
            const LAS unsigned char* vb = lds + (cur) + AT_V + r * 136 + h * 8; \
            bf16x8 kf0[4], kf1[4]; \
_Pragma("unroll") \
            for (int s = 0; s < 4; ++s) { kf0[s] = *(const LAS bf16x8*)(kb + s * 32); kf1[s] = *(const LAS bf16x8*)(kb + 32 * 144 + s * 32); } \
            s16x4 vlo[4], vhi[4]; \
_Pragma("unroll") \
            for (int ks = 0; ks < 4; ++ks) { vlo[ks] = *(const LAS s16x4*)(vb + ks * 32); vhi[ks] = *(const LAS s16x4*)(vb + ks * 32 + 16); } \
            __builtin_amdgcn_sched_barrier(0); \
            p0 = MFMA32(kf0[0], qf[0], zero16()); p1 = MFMA32(kf1[0], qf[0], zero16()); \
_Pragma("unroll") \
            for (int s = 1; s < 4; ++s) { p0 = MFMA32(kf0[s], qf[s], p0); p1 = MFMA32(kf1[s], qf[s], p1); } \
            asm volatile("s_nop 15\n\ts_nop 7" : "+v"(p0), "+v"(p1));        \
            float mxa = max3f(p0[0], p0[1], p1[0]), mxb = max3f(p0[2], p0[3], p1[1]); mxa = max3f(mxa, p1[2], p1[3]); \
_Pragma("unroll") \
            for (int i = 4; i < 16; i += 4) { mxa = max3f(mxa, p0[i], p0[i + 1]); mxb = max3f(mxb, p0[i + 2], p0[i + 3]); mxa = max3f(mxa, p1[i], p1[i + 1]); mxb = max3f(mxb, p1[i + 2], p1[i + 3]); } \
            float mx = max3f(mxa, mxb, mxb); \
            { const auto rr_ = __builtin_amdgcn_permlane32_swap(__float_as_uint(mx), __float_as_uint(mx), false, false);        \
              mx = fmaxf(__uint_as_float(rr_[0]), __uint_as_float(rr_[1])) - mref; } \
            if (__any(mx > 16.f)) { \
                const float d = fmaxf(mx, 0.f), alpha = __builtin_amdgcn_exp2f(-d); \
                mref += d; lrun *= alpha; \
_Pragma("unroll") \
                for (int c = 0; c < 4; ++c) \
_Pragma("unroll") \
                    for (int i = 0; i < 16; ++i) O[c][i] *= alpha; \
            } \
            float rs = 0.f; \
            if (__any(mref != 0.f)) { \
_Pragma("unroll") \
            for (int i = 0; i < 16; ++i) { p0[i] -= mref; p1[i] -= mref; } \
            } \
_Pragma("unroll") \
            for (int i = 0; i < 16; ++i) { p0[i] = __builtin_amdgcn_exp2f(p0[i]); p1[i] = __builtin_amdgcn_exp2f(p1[i]); } \
            float rsa = 0.f, rsb = 0.f;                             \
_Pragma("unroll") \
            for (int i = 0; i < 16; ++i) { rsa += p0[i]; asm volatile("" : "+v"(rsa)); rsb += p1[i]; asm volatile("" : "+v"(rsb)); } \
            rs = rsa + rsb; \
            lrun += rs; \
            bf16x8 pf[4]; pf[0] = pack8<0>(p0); pf[1] = pack8<1>(p0); pf[2] = pack8<0>(p1); pf[3] = pack8<1>(p1); \
_Pragma("unroll") \
            for (int c = 0; c < 4; ++c) { \
                bf16x8 vf[4]; \
_Pragma("unroll") \
                for (int ks = 0; ks < 4; ++ks) vf[ks] = __builtin_shufflevector(vlo[ks], vhi[ks], 0, 1, 2, 3, 4, 5, 6, 7); \
                if (c < 3) { \
_Pragma("unroll") \
                    for (int ks = 0; ks < 4; ++ks) { vlo[ks] = *(const LAS s16x4*)(vb + (c + 1) * 32 * 136 + ks * 32); vhi[ks] = *(const LAS s16x4*)(vb + (c + 1) * 32 * 136 + ks * 32 + 16); } \
                } \
                __builtin_amdgcn_sched_barrier(0); \
_Pragma("unroll") \
                for (int ks = 0; ks < 4; ++ks) O[c] = MFMA32(vf[ks], pf[ks], O[c]); \
                __builtin_amdgcn_sched_barrier(0); \
            } \
        } \
    } while (0)
#define AT_LOAD(KR, VR, t) do { _Pragma("unroll") for (int i = 0; i < 2; ++i) { KR[i] = *(const u32x4*)(ksrc[i] + (size_t)(t) * 64 * 64); VR[i] = *(const u32x4*)(vsrc[i] + (size_t)(t) * 64); } } while (0)
#define AT_WRITE(KR, VR, slot) do { _Pragma("unroll") for (int i = 0; i < 2; ++i) { *(LAS u32x4*)(lds + (slot) + kdst[i]) = KR[i]; \
        *(LAS u32x2*)(lds + (slot) + vdst[i]) = (u32x2){VR[i].x, VR[i].y}; *(LAS u32x2*)(lds + (slot) + vdst[i] + 8) = (u32x2){VR[i].z, VR[i].w}; } } while (0)
    if (wave >= 4) __builtin_amdgcn_s_setprio(1);
#pragma unroll 1
    for (int kt = 0; kt < NT; kt += 2) {
        if (kt + 2 < NT) AT_LOAD(kreg2, vreg2, kt + 2);
        AT_COMPUTE(kt, 0);
        AT_WRITE(kreg, vreg, AT_STAGE);
        __syncthreads();
        if (kt + 3 < NT) AT_LOAD(kreg, vreg, kt + 3);
        AT_COMPUTE(kt + 1, AT_STAGE);
        if (kt + 2 < NT) AT_WRITE(kreg2, vreg2, 0);
        __syncthreads();
    }
#undef AT_COMPUTE
#undef AT_LOAD
#undef AT_WRITE
    __builtin_amdgcn_s_setprio(0);
    const float lt = lrun + __shfl_xor(lrun, 32);
    const float inv = (sub ? lam : 1.f) / lt;
    LAS float* X = (LAS float*)(lds + AT_X + qg * 16384);
    if (sub == 1) {
#pragma unroll
        for (int c = 0; c < 4; ++c)
#pragma unroll
            for (int i = 0; i < 16; ++i) X[(c * 16 + i) * 64 + lane] = O[c][i] * inv;
    }
    __syncthreads();
    if (sub == 0) {
        float ssq = 0.f;
#pragma unroll
        for (int c = 0; c < 4; ++c)
#pragma unroll
            for (int i = 0; i < 16; ++i) { const float o = O[c][i] * inv - X[(c * 16 + i) * 64 + lane]; O[c][i] = o; ssq += o * o; }
        ssq += __shfl_xor(ssq, 32);
        const float rstd = rsqrtf(ssq * (1.f / 128.f) + 1e-6f);
        LAS unsigned char* st = lds + AT_OST + qg * 8704;
#pragma unroll
        for (int c = 0; c < 4; ++c)
#pragma unroll
            for (int i = 0; i < 16; ++i) *(LAS unsigned short*)(st + r * 272 + (32 * c + crow(i, h)) * 2) = f2bf(O[c][i] * rstd);
        asm volatile("s_waitcnt lgkmcnt(0)" ::: "memory");
        const bf16* BGt = (const bf16*)(p.ws + WS_PROJ + (size_t)7 * PROJ_SUB);
        bf16* MX = (bf16*)(p.ws + WS_MIXED);
#pragma unroll
        for (int it = 0; it < 8; ++it) {
            const int row = it * 4 + (lane >> 4), ch = lane & 15;
            const u32x4 ov = *(const LAS u32x4*)(st + row * 272 + ch * 16);
            const size_t m = (size_t)b * SEQ + q0 + 32 * qg + row;
            const u32x4 gv = *(const u32x4*)(BGt + m * 512 + hd * 128 + ch * 8);
            float of[8], gf[8]; unpack8(ov, of); unpack8(gv, gf);
            const f32x4 s0 = *(const f32x4*)(p.subln_g + ch * 8), s1 = *(const f32x4*)(p.subln_g + ch * 8 + 4);
            const float sg[8] = {s0.x, s0.y, s0.z, s0.w, s1.x, s1.y, s1.z, s1.w};
            float y[8];
#pragma unroll
            for (int e = 0; e < 8; ++e) y[e] = of[e] * sg[e] * 0.8f * silu_f(gf[e]);
            u32x4 o; o.x = pk2(y[0], y[1]); o.y = pk2(y[2], y[3]); o.z = pk2(y[4], y[5]); o.w = pk2(y[6], y[7]);
            *(u32x4*)(MX + m * 1024 + 512 + hd * 128 + ch * 8) = o;
        }
    }
}

DI unsigned xb_xcc_id();
DI void p4_phase(const Params& p, LAS unsigned char* lds, int tid, int lane, int wave, int mode = 0) {
    const float lam = __expf(wave_sum(p.lq1[lane] * p.lk1[lane])) - __expf(wave_sum(p.lq2[lane] * p.lk2[lane])) + 0.2f;
    const int myx = (int)(xb_xcc_id() & 7u);
    LAS int* qslot = (LAS int*)(lds + AT_QSLOT);
    for (int qq = 0; qq < 8; ++qq) {
        const int x = (myx + qq) & 7;
        unsigned* ctr = (unsigned*)(p.ws + WS_CTL) + (mode * 8 + x) * 32;
        for (;;) {
            __syncthreads();
            if (tid == 0) *qslot = (int)atomicAdd(ctr, 1u);
            __syncthreads();
            int item = *qslot;
            if (mode == 2) item += 2;
            if (item >= (mode == 1 ? 2 : 130)) break;
            if (item < 2) scan_job(p, lds, 2 * x + item, tid, lane, wave);
            else { const int u = item - 2; attn_unit(p, lds, 2 * x + (u & 1), 63 - (u >> 1), lam, tid, lane, wave); }
        }
    }
}

DI void p5_phase(const Params& p, int tid, int lane, int wave) {
    const float* OG = (const float*)(p.ws + WS_OG);
    const bf16* AG = (const bf16*)(p.ws + WS_PROJ + (size_t)3 * PROJ_SUB);
    bf16* MX = (bf16*)(p.ws + WS_MIXED);
    const int sub = lane >> 4, l16 = lane & 15;
    f32x4 g0 = *(const f32x4*)(p.gdn_g + l16 * 8), g1 = *(const f32x4*)(p.gdn_g + l16 * 8 + 4);
    const float gg[8] = {g0.x, g0.y, g0.z, g0.w, g1.x, g1.y, g1.z, g1.w};
    const int gw = blockIdx.x * 8 + wave, NGW = gridDim.x * 8;
    for (int rowi = gw * 4 + sub; rowi < MT * 4; rowi += NGW * 4) {
        const size_t off = (size_t)rowi * 128 + l16 * 8;
        const f32x4 a = *(const f32x4*)(OG + off), c2 = *(const f32x4*)(OG + off + 4);
        float v[8] = {a.x, a.y, a.z, a.w, c2.x, c2.y, c2.z, c2.w};
        float ss = 0.f;
#pragma unroll
        for (int e = 0; e < 8; ++e) ss += v[e] * v[e];
        ss += __shfl_xor(ss, 1); ss += __shfl_xor(ss, 2); ss += __shfl_xor(ss, 4); ss += __shfl_xor(ss, 8);
        const float rstd = rsqrtf(ss * (1.f / 128.f) + 1e-6f);
        const u32x4 gv = *(const u32x4*)(AG + off);
        float gf[8]; unpack8(gv, gf);
        float y[8];
#pragma unroll
        for (int e = 0; e < 8; ++e) y[e] = v[e] * rstd * gg[e] * silu_f(gf[e]);
        u32x4 o; o.x = pk2(y[0], y[1]); o.y = pk2(y[2], y[3]); o.z = pk2(y[4], y[5]); o.w = pk2(y[6], y[7]);
        const size_t m = (size_t)(rowi >> 2); const int hd = rowi & 3;
        *(u32x4*)(MX + m * 1024 + hd * 128 + l16 * 8) = o;
    }
}

struct EpiOut {
    static constexpr bool PERM = true, AFTER_DRAIN = false;
    const float* x; float* out; const float* gate;
    __device__ __forceinline__ void operator()(const pg8::f32x4 (&acc)[2][2][4][2], const pg8::Unit& u, int wr, int wc, int fr, int fq) const {
        const int col0 = u.pn * 256 + wc * 32 + 8 * fq;
        const int b = (u.pm * 256) / SEQ;
        pg8::f32x4 gv[2][2];
#pragma unroll
        for (int bj = 0; bj < 2; ++bj)
#pragma unroll
            for (int n = 0; n < 2; ++n) gv[bj][n] = *(const pg8::f32x4*)(gate + b * 1024 + col0 + bj * 128 + n * 4);
#pragma unroll
        for (int ai = 0; ai < 2; ++ai)
#pragma unroll
            for (int m = 0; m < 4; ++m) { const size_t off = (size_t)(u.pm * 256 + ai * 128 + wr * 64 + m * 16 + fr) * DM + col0;
#pragma unroll
                for (int bj = 0; bj < 2; ++bj)
#pragma unroll
                    for (int n = 0; n < 2; ++n) { const pg8::f32x4 xv = *(const pg8::f32x4*)(x + off + bj * 128 + n * 4);
                        *(pg8::f32x4*)(out + off + bj * 128 + n * 4) = xv + gv[bj][n] * acc[ai][bj][m][n]; } }
    }
};

#define GAS __attribute__((address_space(1)))
#define XB_TMO      128
#define XB_XCNT(j)  (256  + 64 * (j))
#define XB_XSUB(j)  (1280 + 64 * (j))
#define XB_XGEN(j)  (2304 + 64 * (j))
#define XB_TOP      3328
#define XB_TOPGEN   3392
#define XCD_BAR_WORDS 3456
#define XB_SPIN_CAP (1u << 18)

__device__ __forceinline__ unsigned xb_ld(unsigned* p)              { return __hip_atomic_load(p, __ATOMIC_RELAXED, __HIP_MEMORY_SCOPE_AGENT); }
__device__ __forceinline__ unsigned xb_add(unsigned* p, unsigned v) { return __hip_atomic_fetch_add(p, v, __ATOMIC_RELAXED, __HIP_MEMORY_SCOPE_AGENT); }
__device__ __forceinline__ unsigned xb_xcc_id() { return (unsigned)__builtin_amdgcn_s_getreg((3 << 11) | 20) & 0xFu; }
#define XB_SPIN(cond, bar) do { unsigned _sp = 0; while (cond) { __builtin_amdgcn_s_sleep(1); \
    if ((++_sp & 255u) == 0u) { if (xb_ld(&(bar)[XB_TMO])) break; if (_sp > XB_SPIN_CAP) { atomicAdd(&(bar)[XB_TMO], 1u); break; } } } } while (0)

struct XcdBarrier {
    unsigned* bar; unsigned x;
    volatile LAS unsigned* st;
};

__device__ __forceinline__ XcdBarrier xcd_barrier_post(unsigned* bar, volatile LAS unsigned* st) {
    XcdBarrier b; b.bar = bar; b.x = xb_xcc_id(); b.st = st;
    if (threadIdx.x == 0) (void)xb_add(&bar[XB_XCNT(b.x)], 1u);
    return b;
}
__device__ __forceinline__ void xcd_barrier_complete(unsigned* bar, unsigned x, unsigned& nloc, unsigned& nx) {
    const unsigned G = gridDim.x * gridDim.y * gridDim.z;
    unsigned sum, cnt, mine, sp = 0u;
    for (;;) {
        sum = 0u; cnt = 0u; mine = 0u;
#pragma unroll
        for (unsigned j = 0; j < 16; ++j) { const unsigned c = xb_ld(&bar[XB_XCNT(j)]); sum += c; cnt += (c > 0u) ? 1u : 0u; mine = (j == x) ? c : mine; }
        if (sum == G) break;
        __builtin_amdgcn_s_sleep(1);
        if ((++sp & 255u) == 0u) { if (xb_ld(&bar[XB_TMO])) break; if (sp > XB_SPIN_CAP) { atomicAdd(&bar[XB_TMO], 1u); break; } }
    }
    nloc = mine > 0u ? mine : 1u; nx = cnt > 0u ? cnt : 1u;
}

__device__ __forceinline__ void xcd_barrier(const XcdBarrier& b) {
    asm volatile("s_waitcnt vmcnt(0)" ::: "memory");
    __syncthreads();
    if (threadIdx.x == 0) {
        unsigned* bar = b.bar;
        __builtin_amdgcn_s_waitcnt(0);
        unsigned nloc = b.st[0], nx = b.st[1];
        if (nloc == 0u) { xcd_barrier_complete(bar, b.x, nloc, nx); b.st[0] = nloc; b.st[1] = nx; }
        const unsigned old = xb_add(&bar[XB_XSUB(b.x)], 1u);
        const unsigned gen = old / nloc;
        if (old + 1u == (gen + 1u) * nloc) {
            __builtin_amdgcn_fence(__ATOMIC_RELEASE, "agent");
            asm volatile("s_waitcnt vmcnt(0)" ::: "memory");
            const unsigned og = xb_add(&bar[XB_TOP], 1u);
            const unsigned tg = og / nx;
            if (og + 1u == (tg + 1u) * nx) xb_add(&bar[XB_TOPGEN], 1u);
            else XB_SPIN(xb_ld(&bar[XB_TOPGEN]) == tg, bar);
            __builtin_amdgcn_fence(__ATOMIC_ACQUIRE, "agent");
            xb_add(&bar[XB_XGEN(b.x)], 1u);
            asm volatile("s_waitcnt vmcnt(0)" ::: "memory");
        } else {
            XB_SPIN(xb_ld(&bar[XB_XGEN(b.x)]) == gen, bar);
            __builtin_amdgcn_fence(__ATOMIC_ACQUIRE, "agent");
            asm volatile("s_waitcnt vmcnt(0)" ::: "memory");
        }
    }
    __syncthreads();
}

template <int PH_LO, int PH_HI, int VARIANT = 0>
__global__ void __launch_bounds__(NTHREADS) fwd_kernel(Params p) {
    extern __shared__ __attribute__((aligned(16))) unsigned char lds_raw[];
    LAS unsigned char* lds = (LAS unsigned char*)lds_raw;
    int tid = threadIdx.x, lane = tid & 63; const int wave = __builtin_amdgcn_readfirstlane(tid >> 6);
#define LAUNDER() asm volatile("" : "+v"(tid), "+v"(lane))
#define PH(k) (PH_LO <= (k) && (k) < PH_HI)
    constexpr bool FUSED = (PH_HI - PH_LO) > 1;
    XcdBarrier bar; bar.bar = nullptr; bar.x = 0; bar.st = nullptr;
    if (FUSED) {
        volatile LAS unsigned* misc = (volatile LAS unsigned*)(lds + 147456 + 32);
        if (tid < 2) misc[tid] = 0u;
        __syncthreads();
        bar = xcd_barrier_post((unsigned*)(p.ws + WS_CTL) + 1024, misc);
    }
    if (FUSED && p.ws == nullptr) cg::this_grid().sync();
#define SEAM(k) do { if (PH(k) && PH((k) + 1)) xcd_barrier(bar); } while (0)
    if (PH(0)) p0_phase(p, lds, tid, lane, wave);
    SEAM(0);
    LAUNDER();
    if (PH(1)) p1_phase(p, lds, tid, lane, wave);
    SEAM(1);
    LAUNDER();
    if (PH(2)) {
        pg8::Gemm g{(const pg8::bf16_t*)(p.ws + WS_XN), (const pg8::bf16_t*)(p.ws + WS_WIN), MT, 4096, 1024};
        pg8::StaticOrder S; S.init(MT, 4096, gridDim.x, (int)blockIdx.x);
        pg8::EpiBf16<0> E{(pg8::bf16_t*)(p.ws + WS_PROJ), 512, nullptr, 512, PROJ_SUB / 2, 1.f};
        pg8::gemm_phase<pg8::EpiBf16<0>, pg8::StaticOrder, true, true>(lds, g, S, E);
        __syncthreads();
    }
    SEAM(2);
    LAUNDER();
    if (PH(3)) {
        if (VARIANT != 4) gdn_prep_all(p, lds, tid, lane, wave, VARIANT);
        __syncthreads();
        if (VARIANT != 3 && VARIANT != 5 && VARIANT != 6) for (int it = blockIdx.x; it < 2048; it += gridDim.x) diff_prep_item(p, lds, it, tid, lane, wave);
    }
    SEAM(3);
    if (PH(4)) p4_phase(p, lds, tid, lane, wave, VARIANT);
    SEAM(4);
    LAUNDER();
    if (PH(6)) {
        pg8::Gemm g{(const pg8::bf16_t*)(p.ws + WS_MIXED), (const pg8::bf16_t*)(p.ws + WS_WOUT), MT, 1024, 1024};
        pg8::StaticOrder S; S.init(MT, 1024, gridDim.x, (int)blockIdx.x);
        EpiOut E{p.x, p.out, (const float*)(p.ws + WS_GATE)};
        pg8::gemm_phase<EpiOut, pg8::StaticOrder, true, true>(lds, g, S, E);
    }
#undef PH
#undef SEAM
}

#ifndef N_LAUNCH_MODE
#define N_LAUNCH_MODE 1
#endif

template <int LO, int HI, int VARIANT = 0> static void launch_range(const Params& p, int grid, hipStream_t stream, bool coop) {
    auto kfn = fwd_kernel<LO, HI, VARIANT>;
    (void)hipFuncSetAttribute((const void*)kfn, hipFuncAttributeMaxDynamicSharedMemorySize, LDS_BYTES);
    if (coop) {
        Params pp = p; void* args[] = {&pp};
        hipError_t e = hipLaunchCooperativeKernel((const void*)kfn, dim3(grid), dim3(NTHREADS), args, LDS_BYTES, stream);
        if (e != hipSuccess) fprintf(stderr, "cooperative launch failed: %s (grid %d)\n", hipGetErrorString(e), grid);
    } else {
        hipLaunchKernelGGL(kfn, dim3(grid), dim3(NTHREADS), LDS_BYTES, stream, p);
    }
}

extern "C" void kernel_launch(void* const* d_in, const int* in_sizes, int n_in, void* d_out, int out_size, void* d_ws, size_t ws_size, hipStream_t stream) {
    static int grid = 0;
    if (grid == 0) {
        if (n_in != 19 || ws_size < WS_END) { fprintf(stderr, "kernel_launch: unexpected n_in %d or ws_size %zu (< %zu)\n", n_in, ws_size, (size_t)WS_END); grid = -1; return; }
        int dev = 0, cus = 0, per_cu = 0;
        hipGetDevice(&dev); hipDeviceGetAttribute(&cus, hipDeviceAttributeMultiprocessorCount, dev);
        auto kfn = fwd_kernel<0, 7>;
        (void)hipFuncSetAttribute((const void*)kfn, hipFuncAttributeMaxDynamicSharedMemorySize, LDS_BYTES);
        if (hipOccupancyMaxActiveBlocksPerMultiprocessor(&per_cu, (const void*)kfn, NTHREADS, LDS_BYTES) != hipSuccess || per_cu < 1) { per_cu = 1; (void)hipGetLastError(); }
        grid = cus * per_cu;
        if (grid > 256) grid = 256;
    }
    if (grid < 0) return;
    Params p{};
    p.x = (const float*)d_in[0]; p.c = (const float*)d_in[1]; p.pos = (const int*)d_in[2]; p.norm_g = (const float*)d_in[3]; p.w_ada = (const float*)d_in[4];
    p.b_ada = (const float*)d_in[5]; p.w_in = (const float*)d_in[6]; p.conv_w = (const float*)d_in[7]; p.a_log = (const float*)d_in[8]; p.dt_bias = (const float*)d_in[9];
    p.gdn_g = (const float*)d_in[10]; p.qn_g = (const float*)d_in[11]; p.kn_g = (const float*)d_in[12]; p.lq1 = (const float*)d_in[13]; p.lk1 = (const float*)d_in[14];
    p.lq2 = (const float*)d_in[15]; p.lk2 = (const float*)d_in[16]; p.subln_g = (const float*)d_in[17]; p.w_out = (const float*)d_in[18];
    p.out = (float*)d_out; p.ws = (unsigned char*)d_ws;
#if N_LAUNCH_MODE == 1
    (void)hipMemsetAsync((unsigned char*)d_ws + WS_CTL + 4096, 0, XCD_BAR_WORDS * 4, stream);
    launch_range<0, 7>(p, grid, stream, true);
#else
#ifndef PROBE_DUP
#define PROBE_DUP 0
#endif
#ifndef PROBE_SCAN
#define PROBE_SCAN 0
#endif
    for (int rep = 0; rep < 1 + ((PROBE_DUP >> 0) & 1); ++rep) launch_range<0, 1>(p, grid, stream, false);
    for (int rep = 0; rep < 1 + ((PROBE_DUP >> 1) & 1); ++rep) launch_range<1, 2>(p, grid, stream, false);
    for (int rep = 0; rep < 1 + ((PROBE_DUP >> 2) & 1); ++rep) launch_range<2, 3>(p, grid, stream, false);
#if PROBE_SCAN == 3
    launch_range<3, 4, 3>(p, grid, stream, false);
#elif PROBE_SCAN == 4
    launch_range<3, 4, 4>(p, grid, stream, false);
#elif PROBE_SCAN == 5
    launch_range<3, 4, 5>(p, grid, stream, false);
#elif PROBE_SCAN == 6
    launch_range<3, 4, 6>(p, grid, stream, false);
#endif
    for (int rep = 0; rep < 1 + ((PROBE_DUP >> 3) & 1); ++rep) launch_range<3, 4>(p, grid, stream, false);
#if PROBE_SCAN == 1
    launch_range<4, 5, 1>(p, grid, stream, false);
#elif PROBE_SCAN == 2
    launch_range<4, 5, 2>(p, grid, stream, false);
#endif
    launch_range<4, 5>(p, grid, stream, false);
    for (int rep = 0; rep < 1 + ((PROBE_DUP >> 5) & 1); ++rep) launch_range<5, 6>(p, grid, stream, false);
    for (int rep = 0; rep < 1 + ((PROBE_DUP >> 6) & 1); ++rep) launch_range<6, 7>(p, grid, stream, false);
#endif
}
```

```cpp
#include <hip/hip_runtime.h>
#include <hip/hip_cooperative_groups.h>
#include <cstdio>
#include <cstdint>
namespace cg = cooperative_groups;
namespace pg8 {
#define PG8_LAS __attribute__((address_space(3)))
typedef unsigned short bf16_t;
typedef short bf16x8 __attribute__((ext_vector_type(8)));
typedef float f32x4 __attribute__((ext_vector_type(4)));
typedef unsigned u32x4 __attribute__((ext_vector_type(4)));
constexpr int BM = 256, BK = 64, HALF = 128, HTB = HALF * BK * 2  , STAGE_BYTES = 8 * HTB, NXCD = 8, WGM = 8;

__host__ __device__ __forceinline__ int lds_byte(int r, int c) { const int st = (r >> 4) * 2 + (c >> 5), rr = r & 15, cc = c & 31, ob = rr * 64 + cc * 2; return st * 1024 + (ob ^ (((ob >> 9) & 1) << 5)); }
__host__ __device__ __forceinline__ void stage_rc(int b, int& R, int& C) { const int st = b / 1024, sb = b % 1024, swz = sb ^ (((sb >> 9) & 1) << 5); R = (st >> 1) * 16 + swz / 64; C = (st & 1) * 32 + (swz % 64) / 2; }
__host__ __device__ __forceinline__ int perm32(int rho) { const int n = rho >> 4, i = rho & 15; return 8 * (i >> 2) + 4 * n + (i & 3); }

struct Unit { int pm, pn; };
struct Gemm { const bf16_t* A; const bf16_t* Bt; int M, N, K; };

struct StaticOrder {
    int nM, nN, nwg, G, c;
    __host__ __device__ void init(int M, int N, int G_, int c_) { nM = M / BM; nN = N / BM; nwg = nM * nN; G = G_; c = c_; }
    __host__ __device__ bool next(int i, Unit& u) const {
        const long L = (long)i * G + c; if (L >= nwg) return false;
        int wgid = (int)L; { const int q = nwg / NXCD, r = nwg % NXCD, xcd = wgid % NXCD, off = wgid / NXCD; wgid = (xcd < r ? xcd * (q + 1) : r * (q + 1) + (xcd - r) * q) + off; }
        const int nig = WGM * nN, gid = wgid / nig, fm = gid * WGM, gsz = (nM - fm) < WGM ? (nM - fm) : WGM;
        u.pm = fm + ((wgid % nig) % gsz); u.pn = (wgid % nig) / gsz; return true;
    }
    __device__ __forceinline__ void a_ready(const Unit&) const {}
    __device__ __forceinline__ void done(const Unit&) const {}
};

__device__ __forceinline__ unsigned cvt_pk_bf16(float lo, float hi) { unsigned r; asm volatile("v_cvt_pk_bf16_f32 %0, %1, %2" : "=v"(r) : "v"(lo), "v"(hi)); return r; }
typedef float f32x2 __attribute__((ext_vector_type(2)));
__device__ __forceinline__ f32x2 gelu_pk(f32x2 v) {
    const f32x2 av = __builtin_elementwise_abs(v), d = av * 0.2316418882f + 1.0f;
    f32x2 t; t.x = __builtin_amdgcn_rcpf(d.x); t.y = __builtin_amdgcn_rcpf(d.y);
    f32x2 q = t * 0.5307027145f + (-0.7265760135f); q = q * t + 0.7107068705f; q = q * t + (-0.142248368f); q = q * t + 0.127414796f; q = q * t;
    const f32x2 s = (v * v) * (-0.72134752044f);
    f32x2 e; e.x = __builtin_amdgcn_exp2f(s.x); e.y = __builtin_amdgcn_exp2f(s.y);
    const f32x2 m = v * (q * e), r = v - m;
    f32x2 o; o.x = v.x < 0.f ? m.x : r.x; o.y = v.y < 0.f ? m.y : r.y; return o;
}

template <int ACT  > struct EpiBf16 {
    static constexpr bool PERM = true, AFTER_DRAIN = false; static_assert(ACT == 0 || ACT == 1, "EpiBf16: ACT is 0 (none) or 1 (gelu_pk)");
    bf16_t* O; int ldc; const float* bias; int split_cols; size_t split_stride; float scale0;
    __device__ __forceinline__ void operator()(const f32x4 (&acc)[2][2][4][2], const Unit& u, int wr, int wc, int fr, int fq) const {
        const int row0 = u.pm * BM + wr * 64 + fr; int colt = u.pn * BM; bf16_t* base = O;
        float sc = 1.f; if (split_cols) { const int t = colt / split_cols; base += (size_t)t * split_stride; colt -= t * split_cols; if (t == 0) sc = scale0; }
        const int col0 = colt + wc * 32 + 8 * fq, bcol0 = u.pn * BM + wc * 32 + 8 * fq;
        f32x4 bv[2][2];
#pragma unroll
        for (int bj = 0; bj < 2; ++bj)
#pragma unroll
            for (int n = 0; n < 2; ++n) bv[bj][n] = bias ? *(const f32x4*)(bias + bcol0 + bj * HALF + 4 * n) : (f32x4){0.f, 0.f, 0.f, 0.f};
#pragma unroll
        for (int ai = 0; ai < 2; ++ai)
#pragma unroll
            for (int m = 0; m < 4; ++m) { bf16_t* rowp = base + (size_t)(row0 + ai * HALF + m * 16) * ldc + col0;
#pragma unroll
                for (int bj = 0; bj < 2; ++bj) { f32x4 v0 = acc[ai][bj][m][0] + bv[bj][0], v1 = acc[ai][bj][m][1] + bv[bj][1];
                    if (ACT == 1) { f32x2 a = gelu_pk((f32x2){v0[0], v0[1]}), b = gelu_pk((f32x2){v0[2], v0[3]}), c = gelu_pk((f32x2){v1[0], v1[1]}), d = gelu_pk((f32x2){v1[2], v1[3]});
                        v0 = (f32x4){a.x, a.y, b.x, b.y}; v1 = (f32x4){c.x, c.y, d.x, d.y}; }
                    v0 = v0 * sc; v1 = v1 * sc; u32x4 w; w.x = cvt_pk_bf16(v0[0], v0[1]); w.y = cvt_pk_bf16(v0[2], v0[3]); w.z = cvt_pk_bf16(v1[0], v1[1]); w.w = cvt_pk_bf16(v1[2], v1[3]);
                    *(u32x4*)(rowp + bj * HALF) = w; } }
    }
};
template <class Epi, class Sched, bool ALIGN_EPI = false, bool SP2 = false>
__device__ __forceinline__ void gemm_phase(PG8_LAS unsigned char* lds, const Gemm g, const Sched& S, const Epi& E) {
    const int tid = threadIdx.x, wid = __builtin_amdgcn_readfirstlane(tid >> 6), lane = tid & 63, wr = wid >> 2, wc = wid & 3, fr = lane & 15, fq = lane >> 4;
    const int K = g.K, nt = K / BK;
    unsigned voffA[2], voffB[2];
#pragma unroll
    for (int i = 0; i < 2; ++i) { int R, C; stage_rc(tid * 16 + i * 8192, R, C); const int Rb = Epi::PERM ? ((R & ~31) + perm32(R & 31)) : R;
        voffA[i] = (unsigned)(R * K + C) * 2u; voffB[i] = (unsigned)(Rb * K + C) * 2u; }
    const size_t kstep = (size_t)(BK * 2);
    const size_t hstep = (size_t)HALF * K * 2;
    const size_t tstep = 2 * hstep;
    const unsigned ldsw = (unsigned)wid * 1024u;
    const int aoff = lds_byte(wr * 64 + fr, fq * 8), boff = lds_byte(wc * 32 + fr, fq * 8);
#define PG8_SA(b, h) (((b) * 2 + (h)) * HTB)
#define PG8_SB(b, h) ((4 + (b) * 2 + (h)) * HTB)
#define PG8_STAGE(bufoff, gbase, voff) do { _Pragma("unroll") for (int _i = 0; _i < 2; ++_i) \
        __builtin_amdgcn_global_load_lds((const unsigned*)((const char*)(gbase) + (voff)[_i]), (PG8_LAS unsigned*)(lds + (bufoff) + ldsw + _i * 8192), 16, 0, 0); } while (0)
#define PG8_LDA(dst, b, h) do { _Pragma("unroll") for (int m = 0; m < 4; ++m) _Pragma("unroll") for (int k = 0; k < 2; ++k) dst[m][k] = *(const PG8_LAS bf16x8*)(lds + PG8_SA(b, h) + aoff + m * 2048 + k * 1024); } while (0)
#define PG8_LDB(dst, b, h) do { _Pragma("unroll") for (int n = 0; n < 2; ++n) _Pragma("unroll") for (int k = 0; k < 2; ++k) dst[n][k] = *(const PG8_LAS bf16x8*)(lds + PG8_SB(b, h) + boff + n * 2048 + k * 1024); } while (0)
#define PG8_MMA(ai, bj, At, Bt) do { __builtin_amdgcn_s_setprio(1); _Pragma("unroll") for (int m = 0; m < 4; ++m) _Pragma("unroll") for (int n = 0; n < 2; ++n) _Pragma("unroll") for (int k = 0; k < 2; ++k) \
        acc[ai][bj][m][n] = __builtin_amdgcn_mfma_f32_16x16x32_bf16(Bt[n][k], At[m][k], acc[ai][bj][m][n], 0, 0, 0); __builtin_amdgcn_s_setprio(0); } while (0)
#define PG8_WAIT_V(n) asm volatile("s_waitcnt vmcnt(" #n ")" ::: "memory")
#define PG8_WAIT_L(n) asm volatile("s_waitcnt lgkmcnt(" #n ")" ::: "memory")
#define PG8_BAR __builtin_amdgcn_s_barrier()
#define PG8_SCHED __builtin_amdgcn_sched_barrier(0)
    Unit cur, nxt; int ui = 0;
    if (!S.next(0, cur)) return;
    f32x4 acc[2][2][4][2];
#pragma unroll
    for (int a = 0; a < 2; ++a)
#pragma unroll
        for (int b = 0; b < 2; ++b)
#pragma unroll
            for (int m = 0; m < 4; ++m)
#pragma unroll
                for (int n = 0; n < 2; ++n) acc[a][b][m][n] = (f32x4){0.f, 0.f, 0.f, 0.f};
    bf16x8 At[4][2], B0[2][2], B1[2][2];
    const char* cA = (const char*)g.A + (size_t)cur.pm * tstep; const char* cB = (const char*)g.Bt + (size_t)cur.pn * tstep;
    S.a_ready(cur);
    if constexpr (SP2) {
        PG8_STAGE(PG8_SB(0, 0), cB, voffB); PG8_STAGE(PG8_SB(0, 1), cB + hstep, voffB); PG8_STAGE(PG8_SA(0, 0), cA, voffA); PG8_STAGE(PG8_SA(0, 1), cA + hstep, voffA);
        if (wr == 1) PG8_BAR;
        PG8_WAIT_V(2); PG8_BAR;
        PG8_STAGE(PG8_SB(1, 0), cB + kstep, voffB); PG8_STAGE(PG8_SA(1, 0), cA + kstep, voffA); PG8_STAGE(PG8_SB(1, 1), cB + hstep + kstep, voffB);
        PG8_WAIT_V(6); PG8_BAR;
    } else {
        PG8_STAGE(PG8_SB(0, 0), cB, voffB); PG8_STAGE(PG8_SA(0, 0), cA, voffA); PG8_STAGE(PG8_SB(0, 1), cB + hstep, voffB); PG8_STAGE(PG8_SA(0, 1), cA + hstep, voffA);
        if (wr == 1) PG8_BAR;
        PG8_WAIT_V(4); PG8_BAR;
        PG8_STAGE(PG8_SB(1, 0), cB + kstep, voffB); PG8_STAGE(PG8_SA(1, 0), cA + kstep, voffA); PG8_STAGE(PG8_SB(1, 1), cB + hstep + kstep, voffB);
        PG8_WAIT_V(6); PG8_BAR;
    }
    for (;;) {
        const bool has_next = S.next(ui + 1, nxt);
        const char* nA = has_next ? (const char*)g.A + (size_t)nxt.pm * tstep : cA; const char* nB = has_next ? (const char*)g.Bt + (size_t)nxt.pn * tstep : cB;
        for (int t = 0; t < nt; t += 2) {
            const bool last = (t == nt - 2);
            const char* a1 = cA + (size_t)(t + 1) * kstep;
            const char* a2 = last ? nA : cA + (size_t)(t + 2) * kstep; const char* b2 = last ? nB : cB + (size_t)(t + 2) * kstep;
            const char* a3 = a2 + kstep; const char* b3 = b2 + kstep;
            if (last && has_next) S.a_ready(nxt);
            if constexpr (SP2) {
            PG8_LDB(B0, 0, 0); PG8_LDB(B1, 0, 1); PG8_SCHED; PG8_LDA(At, 0, 0); PG8_STAGE(PG8_SA(1, 1), a1 + hstep, voffA);
            PG8_WAIT_V(8); PG8_WAIT_L(0); PG8_BAR; PG8_MMA(0, 0, At, B0); PG8_MMA(0, 1, At, B1); PG8_BAR; PG8_SCHED;
            PG8_LDA(At, 0, 1); PG8_STAGE(PG8_SB(0, 0), b2, voffB); PG8_STAGE(PG8_SB(0, 1), b2 + hstep, voffB); PG8_STAGE(PG8_SA(0, 0), a2, voffA);
            PG8_WAIT_V(8); PG8_WAIT_L(0); PG8_BAR; PG8_MMA(1, 0, At, B0); PG8_MMA(1, 1, At, B1); PG8_BAR; PG8_SCHED;
            PG8_LDB(B0, 1, 0); PG8_LDB(B1, 1, 1); PG8_SCHED; PG8_LDA(At, 1, 0); PG8_STAGE(PG8_SA(0, 1), a2 + hstep, voffA);
            PG8_WAIT_V(8); PG8_WAIT_L(0); PG8_BAR; PG8_MMA(0, 0, At, B0); PG8_MMA(0, 1, At, B1); PG8_BAR; PG8_SCHED;
            PG8_LDA(At, 1, 1); PG8_STAGE(PG8_SB(1, 0), b3, voffB); PG8_STAGE(PG8_SB(1, 1), b3 + hstep, voffB); PG8_STAGE(PG8_SA(1, 0), a3, voffA);
            PG8_WAIT_V(8); PG8_WAIT_L(0); PG8_BAR; PG8_MMA(1, 0, At, B0); PG8_MMA(1, 1, At, B1); PG8_BAR; PG8_SCHED;
            } else {
            PG8_LDB(B0, 0, 0); PG8_SCHED; PG8_LDA(At, 0, 0); PG8_STAGE(PG8_SA(1, 1), a1 + hstep, voffA);
            PG8_WAIT_L(8); PG8_BAR; PG8_WAIT_L(0); PG8_MMA(0, 0, At, B0); PG8_BAR; PG8_SCHED;
            PG8_LDB(B1, 0, 1); PG8_STAGE(PG8_SB(0, 0), b2, voffB);
            PG8_BAR; PG8_WAIT_L(0); PG8_MMA(0, 1, At, B1); PG8_BAR;
            PG8_LDA(At, 0, 1); PG8_STAGE(PG8_SA(0, 0), a2, voffA);
            PG8_BAR; PG8_WAIT_L(0); PG8_MMA(1, 0, At, B0); PG8_BAR; PG8_SCHED;
            PG8_STAGE(PG8_SB(0, 1), b2 + hstep, voffB);
            PG8_WAIT_V(6); PG8_BAR; PG8_MMA(1, 1, At, B1); PG8_BAR;
            PG8_LDB(B0, 1, 0); PG8_SCHED; PG8_LDA(At, 1, 0); PG8_STAGE(PG8_SA(0, 1), a2 + hstep, voffA);
            PG8_WAIT_L(8); PG8_BAR; PG8_WAIT_L(0); PG8_MMA(0, 0, At, B0); PG8_BAR; PG8_SCHED;
            PG8_LDB(B1, 1, 1); PG8_STAGE(PG8_SB(1, 0), b3, voffB);
            PG8_BAR; PG8_WAIT_L(0); PG8_MMA(0, 1, At, B1); PG8_BAR;
            PG8_LDA(At, 1, 1); PG8_STAGE(PG8_SA(1, 0), a3, voffA);
            PG8_BAR; PG8_WAIT_L(0); PG8_MMA(1, 0, At, B0); PG8_BAR; PG8_SCHED;
            PG8_STAGE(PG8_SB(1, 1), b3 + hstep, voffB);
            PG8_WAIT_V(6); PG8_BAR; PG8_MMA(1, 1, At, B1); PG8_BAR;
            }
        }
        if constexpr (ALIGN_EPI) { if (wr == 0) PG8_BAR; }
        if constexpr (!Epi::AFTER_DRAIN) { E(acc, cur, wr, wc, fr, fq); S.done(cur); }
        if (!has_next) break;
#pragma unroll
        for (int a = 0; a < 2; ++a)
#pragma unroll
            for (int b = 0; b < 2; ++b)
#pragma unroll
                for (int m = 0; m < 4; ++m)
#pragma unroll
                    for (int n = 0; n < 2; ++n) acc[a][b][m][n] = (f32x4){0.f, 0.f, 0.f, 0.f};
        cur = nxt; cA = nA; cB = nB; ++ui;
        if constexpr (ALIGN_EPI) { if (wr == 1) PG8_BAR; }
    }
    PG8_WAIT_V(0);
    if constexpr (!ALIGN_EPI) { if (wr == 0) PG8_BAR; }
    PG8_BAR;
    if constexpr (Epi::AFTER_DRAIN) { E.fused(acc, cur, wr, wc, fr, fq, lds, wid, lane); S.done(cur); }
#undef PG8_SA
#undef PG8_SB
#undef PG8_STAGE
#undef PG8_LDA
#undef PG8_LDB
#undef PG8_MMA
#undef PG8_WAIT_V
#undef PG8_WAIT_L
#undef PG8_BAR
#undef PG8_SCHED
}
}
#define DI __device__ __forceinline__
#define LAS __attribute__((address_space(3)))
typedef unsigned short bf16;
typedef short bf16x8 __attribute__((ext_vector_type(8)));
typedef short s16x4 __attribute__((ext_vector_type(4)));
typedef float f32x4 __attribute__((ext_vector_type(4)));
typedef float f32x16 __attribute__((ext_vector_type(16)));
typedef unsigned u32x4 __attribute__((ext_vector_type(4)));
typedef unsigned u32x2 __attribute__((ext_vector_type(2)));
typedef float f32x2_t __attribute__((ext_vector_type(2)));
typedef __bf16 bf16x2_t __attribute__((ext_vector_type(2)));

constexpr int NB = 4, SEQ = 8192, DM = 1024, MT = NB * SEQ, INW = 4104;
constexpr int NTHREADS = 512;
constexpr size_t MiB = 1u << 20;
constexpr size_t WS_CTL = 0;
constexpr size_t WS_WIN = 1 * MiB;
constexpr size_t WS_WOUT = 9 * MiB;
constexpr size_t WS_PART = 11 * MiB;
constexpr size_t WS_GATE = 12 * MiB;
constexpr size_t WS_GL = 12 * MiB + 65536;
constexpr size_t WS_BETA = 13 * MiB;
constexpr size_t WS_G = 13 * MiB + 512 * 1024;
constexpr size_t WS_XN = 16 * MiB;
constexpr size_t WS_QD = 16 * MiB, WS_KD = 48 * MiB;
constexpr size_t WS_PROJ = 80 * MiB;
constexpr size_t PROJ_SUB = 32 * MiB;
constexpr size_t WS_MIXED = 80 * MiB;
constexpr size_t WS_OG = 208 * MiB;
constexpr size_t WS_SCAN = 336 * MiB;
constexpr size_t SCAN_CHUNK = 73728;
constexpr size_t WS_VT = 480 * MiB;
constexpr size_t WS_END = 512 * MiB;
constexpr int LDS_BYTES = 147456 + 64;

struct Params {
    const float* x; const float* c; const int* pos; const float* norm_g; const float* w_ada; const float* b_ada; const float* w_in;
    const float* conv_w; const float* a_log; const float* dt_bias; const float* gdn_g; const float* qn_g; const float* kn_g;
    const float* lq1; const float* lk1; const float* lq2; const float* lk2; const float* subln_g; const float* w_out;
    float* out; unsigned char* ws;
};

DI unsigned pk2(float lo, float hi) { f32x2_t v = {lo, hi}; bf16x2_t b = __builtin_convertvector(v, bf16x2_t); return __builtin_bit_cast(unsigned, b); }
DI float bflo(unsigned u) { return __uint_as_float(u << 16); }
DI float bfhi(unsigned u) { return __uint_as_float(u & 0xffff0000u); }
DI unsigned short f2bf(float f) { return (unsigned short)(pk2(f, 0.f) & 0xffffu); }
DI float wave_sum(float v) {
#pragma unroll
    for (int o = 1; o < 64; o <<= 1) v += __shfl_xor(v, o);
    return v;
}
DI float max3f(float a, float b, float c) { float r; asm("v_max3_f32 %0, %1, %2, %3" : "=v"(r) : "v"(a), "v"(b), "v"(c)); return r; }
DI int crow(int i, int h) { return (i & 3) + 8 * (i >> 2) + 4 * h; }
DI float silu_f(float v) { return v * __builtin_amdgcn_rcpf(1.f + __expf(-v)); }
#define MFMA32(a, b, c) __builtin_amdgcn_mfma_f32_32x32x16_bf16((a), (b), (c), 0, 0, 0)
template <int S> DI bf16x8 pack8(const f32x16& x) {
    u32x4 p; p.x = pk2(x[8 * S], x[8 * S + 1]); p.y = pk2(x[8 * S + 2], x[8 * S + 3]); p.z = pk2(x[8 * S + 4], x[8 * S + 5]); p.w = pk2(x[8 * S + 6], x[8 * S + 7]);
    return __builtin_bit_cast(bf16x8, p);
}
DI void unpack8(u32x4 w, float* f) { f[0] = bflo(w.x); f[1] = bfhi(w.x); f[2] = bflo(w.y); f[3] = bfhi(w.y); f[4] = bflo(w.z); f[5] = bfhi(w.z); f[6] = bflo(w.w); f[7] = bfhi(w.w); }
DI f32x16 zero16() { f32x16 z; for (int i = 0; i < 16; ++i) z[i] = 0.f; return z; }

DI void p0_transpose_item(const float* W, int K, int ldw, int nblk, bf16* WT, LAS float* scr, int item, int lane, int shift_at, int shift) {
    const int kb = item / nblk, nb = item % nblk, k0 = 64 * kb, n0 = 32 * nb, ns = n0 + (n0 >= shift_at ? shift : 0);
#pragma unroll 8
    for (int i = 0; i < 32; ++i) { const int kk = 2 * i + (lane >> 5); scr[kk * 33 + (lane & 31)] = W[(size_t)(k0 + kk) * ldw + ns + (lane & 31)]; }
    asm volatile("s_waitcnt lgkmcnt(0)" ::: "memory");
    const int c = lane & 7;
#pragma unroll
    for (int j = 0; j < 4; ++j) { const int n = (lane >> 3) + 8 * j; const LAS float* s = scr + (8 * c) * 33 + n;
        u32x4 o; o.x = pk2(s[0 * 33], s[1 * 33]); o.y = pk2(s[2 * 33], s[3 * 33]); o.z = pk2(s[4 * 33], s[5 * 33]); o.w = pk2(s[6 * 33], s[7 * 33]);
        *(u32x4*)(WT + (size_t)(n0 + n) * K + k0 + 8 * c) = o; }
    asm volatile("s_waitcnt lgkmcnt(0)" ::: "memory");
}
DI void p0_phase(const Params& p, LAS unsigned char* lds, int tid, int lane, int wave) {
    LAS float* sc = (LAS float*)lds;
    for (int i = tid; i < 4096; i += NTHREADS) sc[i] = silu_f(p.c[i]);
    __syncthreads();
    float* part = (float*)(p.ws + WS_PART);
    const int gw = blockIdx.x * 8 + wave, NGW = gridDim.x * 8;
    for (int it = gw; it < 768; it += NGW) {
        {
            const int kp = it / 48, cgp = it % 48, j = cgp * 64 + lane;
            float a0 = 0.f, a1 = 0.f, a2 = 0.f, a3 = 0.f;
            const float* w = p.w_ada + (size_t)(kp * 64) * 3072 + j;
#pragma unroll 8
            for (int k = 0; k < 64; ++k) { const float wv = w[(size_t)k * 3072]; const int kk = kp * 64 + k;
                a0 += sc[kk] * wv; a1 += sc[1024 + kk] * wv; a2 += sc[2048 + kk] * wv; a3 += sc[3072 + kk] * wv; }
            part[(size_t)(kp * 4 + 0) * 3072 + j] = a0; part[(size_t)(kp * 4 + 1) * 3072 + j] = a1;
            part[(size_t)(kp * 4 + 2) * 3072 + j] = a2; part[(size_t)(kp * 4 + 3) * 3072 + j] = a3;
        }
    }
    if (blockIdx.x == 0) for (int i = tid; i < 1024; i += NTHREADS) ((unsigned*)(p.ws + WS_CTL))[i] = 0u;
}

DI void p1_phase(const Params& p, LAS unsigned char* lds, int tid, int lane, int wave) {
    LAS float* Ak = (LAS float*)lds; LAS float* Bk = Ak + 1024; LAS float* W8 = Bk + 1024;
    const float* part = (const float*)(p.ws + WS_PART);
    float* gate = (float*)(p.ws + WS_GATE);
    bf16* XN = (bf16*)(p.ws + WS_XN);
    float* BETA = (float*)(p.ws + WS_BETA); float* GG = (float*)(p.ws + WS_G);
    for (int i = tid; i < 8192; i += NTHREADS) W8[(i & 7) * 1024 + (i >> 3)] = p.w_in[(size_t)(i >> 3) * INW + 1536 + (i & 7)];
    {
        LAS float* scr = (LAS float*)(lds + 40960 + wave * 8704);
        const int gw = blockIdx.x * 8 + wave, NGW = gridDim.x * 8;
        for (int it = gw; it < 2048 + 512; it += NGW) {
            if (it < 2048) p0_transpose_item(p.w_in, 1024, INW, 128, (bf16*)(p.ws + WS_WIN), scr, it, lane, 1536, 8);
            else p0_transpose_item(p.w_out, 1024, 1024, 32, (bf16*)(p.ws + WS_WOUT), scr, it - 2048, lane, 1 << 30, 0);
        }
    }
    for (int rb = blockIdx.x; rb < 256; rb += gridDim.x) {
        const int b = rb >> 6;
        __syncthreads();
        for (int k = tid; k < 1024; k += NTHREADS) {
            float sh = p.b_ada[k], scl = p.b_ada[1024 + k];
            for (int kp = 0; kp < 16; ++kp) { sh += part[(size_t)(kp * 4 + b) * 3072 + k]; scl += part[(size_t)(kp * 4 + b) * 3072 + 1024 + k]; }
            Ak[k] = p.norm_g[k] * (1.f + scl); Bk[k] = sh;
            if ((rb & 63) == 0) { float g = p.b_ada[2048 + k]; for (int kp = 0; kp < 16; ++kp) g += part[(size_t)(kp * 4 + b) * 3072 + 2048 + k]; gate[b * 1024 + k] = g; }
        }
        __syncthreads();
        for (int i = 0; i < 16; ++i) {
            const int m = rb * 128 + wave * 16 + i;
            const f32x4* xr = (const f32x4*)(p.x + (size_t)m * DM) + lane;
            f32x4 v[4]; float ss = 0.f;
#pragma unroll
            for (int j = 0; j < 4; ++j) { v[j] = xr[64 * j]; ss += (v[j].x * v[j].x + v[j].y * v[j].y) + (v[j].z * v[j].z + v[j].w * v[j].w); }
            const float rstd = rsqrtf(wave_sum(ss) * (1.f / 1024.f) + 1e-6f);
            float d8[8];
#pragma unroll
            for (int cidx = 0; cidx < 8; ++cidx) d8[cidx] = 0.f;
#pragma unroll
            for (int j = 0; j < 4; ++j) {
                const int k0 = 4 * lane + 256 * j; float hv[4];
                const f32x4 av = *(const LAS f32x4*)(Ak + k0), bv = *(const LAS f32x4*)(Bk + k0);
#pragma unroll
                for (int e = 0; e < 4; ++e) hv[e] = v[j][e] * rstd * av[e] + bv[e];
#pragma unroll
                for (int cidx = 0; cidx < 8; ++cidx) { const f32x4 wv = *(const LAS f32x4*)(W8 + cidx * 1024 + k0);
                    d8[cidx] += (hv[0] * wv.x + hv[1] * wv.y) + (hv[2] * wv.z + hv[3] * wv.w); }
                u32x2 o; o.x = pk2(hv[0], hv[1]); o.y = pk2(hv[2], hv[3]);
                *(u32x2*)(XN + (size_t)m * DM + k0) = o;
                asm volatile("" ::: "memory");
            }
            float mine = 0.f;
#pragma unroll
            for (int cidx = 0; cidx < 8; ++cidx) { const float t = wave_sum(d8[cidx]); mine = ((lane & 7) == cidx) ? t : mine; }
            if (lane < 4) BETA[(size_t)m * 4 + lane] = 1.f / (1.f + __expf(-mine));
            else if (lane < 8) { const int hh = lane - 4; const float z = mine + p.dt_bias[hh];
                const float sp = fmaxf(z, 0.f) + log1pf(__expf(-fabsf(z)));
                GG[(size_t)m * 4 + hh] = -__expf(p.a_log[hh]) * sp; }
        }
    }
}

constexpr int P3_QS = 0, P3_KS = 17408, P3_KT = 34816, P3_VBT = 72192, P3_MS = 109568, P3_TS = 126976, P3_SM = 136192;
DI int tro(int row) { return row * 144 + ((row >> 3) << 4); }
#define P3_COMMON \
    const int bh = item >> 7, n = item & 127, b = bh >> 2, hd = bh & 3; \
    const size_t m0 = (size_t)b * SEQ + (size_t)n * 64; \
    const int KTo = P3_KT + pb * 18688, VBo = P3_VBT + pb * 18688; \
    LAS float* GC = (LAS float*)(lds + P3_SM + pb * 1280); LAS float* BE = GC + 64; LAS float* EG = GC + 128; LAS float* KDS = GC + 192; LAS float* BG = GC + 256; \
    const float* BETA = (const float*)(p.ws + WS_BETA); const float* GG = (const float*)(p.ws + WS_G); \
    unsigned char* cb = p.ws + WS_SCAN + (size_t)item * SCAN_CHUNK; \
    const int r = lane & 31, h = lane >> 5; \
    (void)b; (void)hd; (void)m0; (void)KTo; (void)VBo; (void)GC; (void)BE; (void)EG; (void)KDS; (void)BG; (void)BETA; (void)GG; (void)cb; (void)r; (void)h; (void)n;

DI void gdn_s1(const Params& p, LAS unsigned char* lds, int item, int pb, int tid, int lane, int wave) {
    asm volatile("" : "+v"(tid), "+v"(lane));
    P3_COMMON
    if (wave == 1) {
        float g = GG[(m0 + lane) * 4 + hd];
#pragma unroll
        for (int o = 1; o < 64; o <<= 1) { const float t = __shfl_up(g, o); if (lane >= o) g += t; }
        const float glast = __shfl(g, 63);
        const float be = BETA[(m0 + lane) * 4 + hd];
        GC[lane] = g; BE[lane] = be; const float eg = __expf(g); EG[lane] = eg; KDS[lane] = __expf(glast - g); BG[lane] = be * eg;
        if (lane == 63) ((float*)(p.ws + WS_GL))[item] = eg;
    }
    const int t7 = tid - 64;
    u32x4 raw[7][4];
#pragma unroll
    for (int k = 0; k < 7; ++k) {
        const int u = t7 + 448 * k, which = u >> 10, tt = (u & 1023) >> 4, ch0 = (u & 15) * 8, tpos = n * 64 + tt;
        const bf16* X = (const bf16*)(p.ws + WS_PROJ + (size_t)(which < 3 ? which : 0) * PROJ_SUB);
#pragma unroll
        for (int j = 0; j < 4; ++j) {
            raw[k][j] = (u32x4){0u, 0u, 0u, 0u};
            if (u < 3072 && tpos - 3 + j >= 0) raw[k][j] = *(const u32x4*)(X + (m0 + tt - 3 + j) * 512 + hd * 128 + ch0);
        }
    }
#pragma unroll
    for (int k = 0; k < 7; ++k) {
        const int u = t7 + 448 * k, which = __builtin_amdgcn_readfirstlane(u >> 10), tt = (u & 1023) >> 4, ch0 = (u & 15) * 8;
        const bool valid = u < 3072;
        const int cbase = (which < 3 ? which : 0) * 512 + hd * 128 + ch0;
        float cw[4][8];
#pragma unroll
        for (int j = 0; j < 4; ++j) { const f32x4 a = *(const f32x4*)(p.conv_w + (size_t)j * 1536 + cbase), c2 = *(const f32x4*)(p.conv_w + (size_t)j * 1536 + cbase + 4);
            cw[j][0] = a.x; cw[j][1] = a.y; cw[j][2] = a.z; cw[j][3] = a.w; cw[j][4] = c2.x; cw[j][5] = c2.y; cw[j][6] = c2.z; cw[j][7] = c2.w; }
        float acc[8];
#pragma unroll
        for (int e = 0; e < 8; ++e) acc[e] = 0.f;
#pragma unroll
        for (int j = 0; j < 4; ++j) {
            float f[8]; unpack8(raw[k][j], f);
#pragma unroll
            for (int e = 0; e < 8; ++e) acc[e] += cw[j][e] * f[e];
        }
#pragma unroll
        for (int e = 0; e < 8; ++e) acc[e] = silu_f(acc[e]);
        if (which < 2) {
            float ss = 0.f;
#pragma unroll
            for (int e = 0; e < 8; ++e) ss += acc[e] * acc[e];
            ss += __shfl_xor(ss, 1); ss += __shfl_xor(ss, 2); ss += __shfl_xor(ss, 4); ss += __shfl_xor(ss, 8);
            const float inv = rsqrtf(ss + 1e-6f) * (which == 0 ? 0.08838834764831845f : 1.f);
#pragma unroll
            for (int e = 0; e < 8; ++e) acc[e] *= inv;
            u32x4 o; o.x = pk2(acc[0], acc[1]); o.y = pk2(acc[2], acc[3]); o.z = pk2(acc[4], acc[5]); o.w = pk2(acc[6], acc[7]);
            *(LAS u32x4*)(lds + (which == 0 ? P3_QS : P3_KS) + tt * 272 + ch0 * 2) = o;
            if (which == 1) {
#pragma unroll
                for (int e = 0; e < 8; ++e) *(LAS unsigned short*)(lds + KTo + tro(ch0 + e) + tt * 2) = f2bf(acc[e]);
            }
        } else if (valid) {
            const float be = BETA[(m0 + tt) * 4 + hd];
#pragma unroll
            for (int e = 0; e < 8; ++e) *(LAS unsigned short*)(lds + VBo + tro(ch0 + e) + tt * 2) = f2bf(acc[e] * be);
        }
    }
}
DI void gdn_s2(const Params& p, LAS unsigned char* lds, int item, int pb, int tid, int lane, int wave) {
    asm volatile("" : "+v"(tid), "+v"(lane));
    P3_COMMON
    {
        const int w4 = wave & 3, R = w4 >> 1, C = w4 & 1;
        const bool isG = wave < 4;
        f32x16 acc = zero16();
        const bool zero_tile = isG ? (R == 0 && C == 1) : (R == 1 && C == 0);
        if (!zero_tile) {
            bf16x8 fa[8], fb[8];
            const LAS unsigned char* Ab = lds + P3_KS + (32 * R + r) * 272 + h * 16;
            const LAS unsigned char* Bb = lds + (isG ? P3_KS : P3_QS) + (32 * C + r) * 272 + h * 16;
#pragma unroll
            for (int s = 0; s < 8; ++s) { fa[s] = *(const LAS bf16x8*)(Ab + s * 32); fb[s] = *(const LAS bf16x8*)(Bb + s * 32); }
            __builtin_amdgcn_sched_barrier(0);
#pragma unroll
            for (int s = 0; s < 8; ++s) acc = MFMA32(fa[s], fb[s], acc);
        }
        const int col = 32 * C + r; const float gcc = GC[col];
        float gcr[16], ber[16];
#pragma unroll
        for (int g4 = 0; g4 < 4; ++g4) { const f32x4 gv = *(const LAS f32x4*)(GC + 32 * R + 8 * g4 + 4 * h), bv = *(const LAS f32x4*)(BE + 32 * R + 8 * g4 + 4 * h);
            gcr[4 * g4] = gv.x; gcr[4 * g4 + 1] = gv.y; gcr[4 * g4 + 2] = gv.z; gcr[4 * g4 + 3] = gv.w; ber[4 * g4] = bv.x; ber[4 * g4 + 1] = bv.y; ber[4 * g4 + 2] = bv.z; ber[4 * g4 + 3] = bv.w; }
        if (isG) {
#pragma unroll
            for (int i = 0; i < 16; ++i) { const int row = 32 * R + crow(i, h);
                const float e = __expf(fminf(gcr[i] - gcc, 0.f));
                const float v = ber[i] * acc[i] * e;
                *(LAS float*)(lds + P3_MS + row * 272 + col * 4) = (col < row) ? v : 0.f; }
        } else {
            f32x16 o;
#pragma unroll
            for (int i = 0; i < 16; ++i) { const int row = 32 * R + crow(i, h);
                const float e = __expf(fminf(gcc - gcr[i], 0.f));
                const float v = acc[i] * e;
                o[i] = (row <= col) ? v : 0.f; }
            unsigned char* at = cb + 49152;
            *(bf16x8*)(at + ((size_t)(C * 4 + 2 * R + 0) * 64 + lane) * 16) = pack8<0>(o);
            *(bf16x8*)(at + ((size_t)(C * 4 + 2 * R + 1) * 64 + lane) * 16) = pack8<1>(o);
        }
    }
        for (int f = wave; f < 32; f += 8) {
            if (f < 16) {
                const int Rc = f >> 3, s = f & 7, cc = 32 * Rc + r;
                const u32x2 lo = *(const LAS u32x2*)(lds + P3_QS + cc * 272 + (16 * s + 4 * h) * 2), hi = *(const LAS u32x2*)(lds + P3_QS + cc * 272 + (16 * s + 8 + 4 * h) * 2);
                const float eg = EG[cc];
                u32x4 o; o.x = pk2(bflo(lo.x) * eg, bfhi(lo.x) * eg); o.y = pk2(bflo(lo.y) * eg, bfhi(lo.y) * eg); o.z = pk2(bflo(hi.x) * eg, bfhi(hi.x) * eg); o.w = pk2(bflo(hi.y) * eg, bfhi(hi.y) * eg);
                *(u32x4*)(cb + 16384 + ((size_t)f * 64 + lane) * 16) = o;
            } else {
                const int f2 = f - 16, Rd = f2 >> 2, s = f2 & 3, dk = 32 * Rd + r, c0 = 16 * s + 4 * h;
                const u32x2 lo = *(const LAS u32x2*)(lds + KTo + tro(dk) + c0 * 2), hi = *(const LAS u32x2*)(lds + KTo + tro(dk) + (c0 + 8) * 2);
                const f32x4 k0v = *(const LAS f32x4*)(KDS + c0), k1v = *(const LAS f32x4*)(KDS + c0 + 8);
                u32x4 o; o.x = pk2(bflo(lo.x) * k0v.x, bfhi(lo.x) * k0v.y); o.y = pk2(bflo(lo.y) * k0v.z, bfhi(lo.y) * k0v.w);
                o.z = pk2(bflo(hi.x) * k1v.x, bfhi(hi.x) * k1v.y); o.w = pk2(bflo(hi.y) * k1v.z, bfhi(hi.y) * k1v.w);
                *(u32x4*)(cb + 32768 + ((size_t)f2 * 64 + lane) * 16) = o;
            }
        }
}
DI void gdn_solve(LAS unsigned char* lds, int lane) {
    asm volatile("" : "+v"(lane));
    {
        f32x2_t tp[32]; const float lanef = (float)lane;
        int vz = 0; asm volatile("" : "+v"(vz));
        const LAS unsigned char* msb = lds + P3_MS + vz;
        f32x4 mcur[16], mnxt[16];
#pragma unroll
        for (int j4 = 0; j4 < 16; ++j4) { mcur[j4] = (f32x4){0.f, 0.f, 0.f, 0.f}; mnxt[j4] = mcur[j4]; }
#pragma unroll
        for (int i = 0; i < 64; ++i) {
            if (i + 1 < 64) {
#pragma unroll
                for (int j4 = 0; j4 < (i + 1 + 3) / 4; ++j4) mnxt[j4] = *(const LAS f32x4*)(msb + (i + 1) * 272 + j4 * 16);
            }
            __builtin_amdgcn_sched_barrier(0);
            f32x2_t acc2 = {0.f, 0.f}, acc3 = {0.f, 0.f}, acc4 = {0.f, 0.f}, acc5 = {0.f, 0.f};
#pragma unroll
            for (int j4 = 0; j4 < (i + 3) / 4; ++j4) {
                const f32x4 mv = mcur[j4];
                if (j4 & 1) {
                    if (4 * j4 + 1 < i) acc4 += (f32x2_t){mv.x, mv.y} * tp[2 * j4];
                    else if (4 * j4 + 0 < i) acc4.x += mv.x * tp[2 * j4].x;
                    if (4 * j4 + 3 < i) acc5 += (f32x2_t){mv.z, mv.w} * tp[2 * j4 + 1];
                    else if (4 * j4 + 2 < i) acc5.x += mv.z * tp[2 * j4 + 1].x;
                } else {
                    if (4 * j4 + 1 < i) acc2 += (f32x2_t){mv.x, mv.y} * tp[2 * j4];
                    else if (4 * j4 + 0 < i) acc2.x += mv.x * tp[2 * j4].x;
                    if (4 * j4 + 3 < i) acc3 += (f32x2_t){mv.z, mv.w} * tp[2 * j4 + 1];
                    else if (4 * j4 + 2 < i) acc3.x += mv.z * tp[2 * j4 + 1].x;
                }
            }
            acc2 = (acc2 + acc3) + (acc4 + acc5);
            const float a = fmaxf(0.f, 1.f - fabsf(lanef - (float)i)) - (acc2.x + acc2.y);
            if (i & 1) tp[i >> 1].y = a; else tp[i >> 1].x = a;
            *(LAS unsigned short*)(lds + P3_TS + i * 144 + lane * 2) = f2bf(a);
            __builtin_amdgcn_sched_barrier(0);
#pragma unroll
            for (int j4 = 0; j4 < 16; ++j4) mcur[j4] = mnxt[j4];
        }
    }
}
DI void gdn_s4(const Params& p, LAS unsigned char* lds, int item, int pb, int tid, int lane, int wave) {
    asm volatile("" : "+v"(tid), "+v"(lane));
    P3_COMMON
    {
        const int Rd = wave >> 1, Cc = wave & 1, Rc = wave >> 2, Cv = wave & 3;
        u32x4 kr[4]; f32x4 b0[4], b1[4]; bf16x8 tb[4], ta[4], vb[4];
#pragma unroll
        for (int s = 0; s < 4; ++s) {
            kr[s] = *(const LAS u32x4*)(lds + KTo + tro(32 * Rd + r) + (16 * s + 8 * h) * 2);
            b0[s] = *(const LAS f32x4*)(BG + 16 * s + 8 * h); b1[s] = *(const LAS f32x4*)(BG + 16 * s + 8 * h + 4);
            tb[s] = *(const LAS bf16x8*)(lds + P3_TS + (32 * Cc + r) * 144 + (16 * s + 8 * h) * 2);
            ta[s] = *(const LAS bf16x8*)(lds + P3_TS + (32 * Rc + r) * 144 + (16 * s + 8 * h) * 2);
            vb[s] = *(const LAS bf16x8*)(lds + VBo + tro(32 * Cv + r) + (16 * s + 8 * h) * 2);
        }
        __builtin_amdgcn_sched_barrier(0);
        f32x16 ua = zero16();
#pragma unroll
        for (int s = 0; s < 4; ++s) ua = MFMA32(ta[s], vb[s], ua);
        f32x16 acc = zero16();
#pragma unroll
        for (int s = 0; s < 4; ++s) {
            u32x4 ka; ka.x = pk2(bflo(kr[s].x) * b0[s].x, bfhi(kr[s].x) * b0[s].y); ka.y = pk2(bflo(kr[s].y) * b0[s].z, bfhi(kr[s].y) * b0[s].w);
            ka.z = pk2(bflo(kr[s].z) * b1[s].x, bfhi(kr[s].z) * b1[s].y); ka.w = pk2(bflo(kr[s].w) * b1[s].z, bfhi(kr[s].w) * b1[s].w);
            acc = MFMA32(__builtin_bit_cast(bf16x8, ka), tb[s], acc);
        }
#pragma unroll
        for (int i = 0; i < 16; ++i) acc[i] = -acc[i];
        *(bf16x8*)(cb + ((size_t)(Cc * 8 + 2 * Rd + 0) * 64 + lane) * 16) = pack8<0>(acc);
        *(bf16x8*)(cb + ((size_t)(Cc * 8 + 2 * Rd + 1) * 64 + lane) * 16) = pack8<1>(acc);
        unsigned char* up = cb + 57344 + ((size_t)(Rc * 4 + Cv) * 64 + lane) * 32;
        *(bf16x8*)(up) = pack8<0>(ua); *(bf16x8*)(up + 16) = pack8<1>(ua);
    }
}
DI void gdn_prep_all(const Params& p, LAS unsigned char* lds, int tid, int lane, int wave, const int abl = 0) {
    const int G = (int)gridDim.x, first = (int)blockIdx.x;
    if (first >= 2048) return;
    if (wave >= 1) gdn_s1(p, lds, first, 0, tid, lane, wave);
    __syncthreads();
    gdn_s2(p, lds, first, 0, tid, lane, wave);
    __syncthreads();
    int pb = 0;
    for (int it = first; it < 2048; it += G, pb ^= 1) {
        const int nx = it + G;
        if (wave == 0) { if (abl != 5) gdn_solve(lds, lane); }
        else if (nx < 2048 && abl != 6) gdn_s1(p, lds, nx, pb ^ 1, tid, lane, wave);
        __syncthreads();
        gdn_s4(p, lds, it, pb, tid, lane, wave);
        if (nx < 2048) gdn_s2(p, lds, nx, pb ^ 1, tid, lane, wave);
        __syncthreads();
    }
}

DI void diff_prep_item(const Params& p, LAS unsigned char* lds, int item, int tid, int lane, int wave) {
    asm volatile("" : "+v"(tid), "+v"(lane));
    const int bh = item >> 7, n = item & 127, b = bh >> 2, hd = bh & 3;
    const size_t m0 = (size_t)b * SEQ + (size_t)n * 64;
    const int tt = tid >> 3, part = tid & 7, d0 = part * 8;
    LAS float* CS = (LAS float*)(lds + 32768); LAS float* SN = CS + 512;
    u32x4 rawqk[2][2], rawv[2];
#pragma unroll
    for (int which = 0; which < 2; ++which)
#pragma unroll
        for (int sub = 0; sub < 2; ++sub) rawqk[which][sub] = *(const u32x4*)((const bf16*)(p.ws + WS_PROJ + (size_t)(4 + which) * PROJ_SUB) + (m0 + tt) * 512 + hd * 128 + sub * 64 + d0);
#pragma unroll
    for (int i = 0; i < 2; ++i) { const int pc = tid + 512 * i, tk = pc >> 4, dv0 = (pc & 15) * 8;
        rawv[i] = *(const u32x4*)((const bf16*)(p.ws + WS_PROJ + (size_t)6 * PROJ_SUB) + (m0 + tk) * 512 + hd * 128 + dv0); }
    {
        const float invf = exp2f(-(float)part * (18.931568569324174f / 8.f));
        const float ang = (float)p.pos[m0 + tt] * invf;
        double xr = (double)ang * 0.15915494309189535; xr -= __builtin_rint(xr);
        const float fr = (float)xr;
        CS[tid] = __builtin_amdgcn_cosf(fr); SN[tid] = __builtin_amdgcn_sinf(fr);
    }
    __syncthreads();
#pragma unroll
    for (int which = 0; which < 2; ++which) {
        const float* gn = which ? p.kn_g : p.qn_g;
        bf16* dst = (bf16*)(p.ws + (which ? WS_KD : WS_QD));
#pragma unroll
        for (int sub = 0; sub < 2; ++sub) {
            float y[8]; unpack8(rawqk[which][sub], y);
            float ss = 0.f;
#pragma unroll
            for (int e = 0; e < 8; ++e) ss += y[e] * y[e];
            ss += __shfl_xor(ss, 1); ss += __shfl_xor(ss, 2); ss += __shfl_xor(ss, 4);
            const float rstd = rsqrtf(ss * (1.f / 64.f) + 1e-6f);
#pragma unroll
            for (int e = 0; e < 8; ++e) y[e] = y[e] * rstd * gn[d0 + e];
            float oth[8];
#pragma unroll
            for (int e = 0; e < 8; ++e) oth[e] = __shfl_xor(y[e], 1);
            if (part < 2) {
#pragma unroll
                for (int e = 0; e < 8; ++e) {
                    const float cs = CS[tt * 8 + e], sn = SN[tt * 8 + e];
                    y[e] = (part == 0) ? (y[e] * cs - oth[e] * sn) : (y[e] * cs + oth[e] * sn);
                }
            }
            const float qs = which ? 1.f : 0.125f * 1.4426950408889634f;
            u32x4 o; o.x = pk2(y[0] * qs, y[1] * qs); o.y = pk2(y[2] * qs, y[3] * qs); o.z = pk2(y[4] * qs, y[5] * qs); o.w = pk2(y[6] * qs, y[7] * qs);
            *(u32x4*)(dst + ((size_t)(bh * 2 + sub) * SEQ + (size_t)n * 64 + tt) * 64 + d0) = o;
        }
    }
#pragma unroll
    for (int i = 0; i < 2; ++i) { const int pc = tid + 512 * i, tk = pc >> 4, dv0 = (pc & 15) * 8;
        const unsigned w4[4] = {rawv[i].x, rawv[i].y, rawv[i].z, rawv[i].w};
#pragma unroll
        for (int e = 0; e < 8; ++e) *(LAS unsigned short*)(lds + tro(dv0 + e) + tk * 2) = (unsigned short)((e & 1) ? (w4[e >> 1] >> 16) : (w4[e >> 1] & 0xffffu)); }
    __syncthreads();
    bf16* VT = (bf16*)(p.ws + WS_VT);
#pragma unroll
    for (int i = 0; i < 2; ++i) { const int pc = tid + 512 * i, dv = pc >> 3, tk0 = (pc & 7) * 8;
        const u32x4 v = *(const LAS u32x4*)(lds + tro(dv) + tk0 * 2);
        *(u32x4*)(VT + ((size_t)bh * 128 + dv) * SEQ + (size_t)n * 64 + tk0) = v; }
    __syncthreads();
}

constexpr int SC_BUF = 57344, SC_OB = 114688;
DI void scan_post(const Params& p, LAS unsigned char* lds, int bh, int n, int pt) {
    const int b = bh >> 2, hd = bh & 3, row = pt >> 2, q = pt & 3;
    const size_t m = (size_t)b * SEQ + (size_t)n * 64 + row;
    const bf16* AG = (const bf16*)(p.ws + WS_PROJ + (size_t)3 * PROJ_SUB) + m * 512 + hd * 128 + q * 32;
    u32x4 gv[4], ov[4];
#pragma unroll
    for (int j = 0; j < 4; ++j) gv[j] = *(const u32x4*)(AG + j * 8);
#pragma unroll
    for (int j = 0; j < 4; ++j) ov[j] = *(const LAS u32x4*)(lds + SC_OB + (n & 1) * 16384 + row * 256 + q * 64 + j * 16);
    float o[32], g[32];
#pragma unroll
    for (int j = 0; j < 4; ++j) { unpack8(ov[j], o + 8 * j); unpack8(gv[j], g + 8 * j); }
    float ss = 0.f;
#pragma unroll
    for (int j = 0; j < 32; ++j) ss += o[j] * o[j];
    ss += __shfl_xor(ss, 1); ss += __shfl_xor(ss, 2);
    const float rstd = rsqrtf(ss * (1.f / 128.f) + 1e-6f);
    bf16* MX = (bf16*)(p.ws + WS_MIXED) + m * 1024 + hd * 128 + q * 32;
#pragma unroll
    for (int j = 0; j < 4; ++j) {
        const f32x4 w0 = *(const f32x4*)(p.gdn_g + q * 32 + j * 8), w1 = *(const f32x4*)(p.gdn_g + q * 32 + j * 8 + 4);
        const float wg[8] = {w0.x, w0.y, w0.z, w0.w, w1.x, w1.y, w1.z, w1.w};
        float y[8];
#pragma unroll
        for (int e = 0; e < 8; ++e) y[e] = o[8 * j + e] * rstd * wg[e] * silu_f(g[8 * j + e]);
        u32x4 w; w.x = pk2(y[0], y[1]); w.y = pk2(y[2], y[3]); w.z = pk2(y[4], y[5]); w.w = pk2(y[6], y[7]);
        *(u32x4*)(MX + j * 8) = w;
    }
}
DI void scan_job(const Params& p, LAS unsigned char* lds, int bh, int tid, int lane, int wave) {
    asm volatile("" : "+v"(tid), "+v"(lane));
    const int r = lane & 31, h = lane >> 5;
    const unsigned char* gsrc = p.ws + WS_SCAN + (size_t)(bh * 128) * SCAN_CHUNK;
    if (wave >= 4) {
        const int pt = tid - 256;
        u32x4 pr[14];
#pragma unroll
        for (int i = 0; i < 14; ++i) pr[i] = *(const u32x4*)(gsrc + (size_t)(pt + 256 * i) * 16);
#pragma unroll
        for (int i = 0; i < 14; ++i) *(LAS u32x4*)(lds + (pt + 256 * i) * 16) = pr[i];
#pragma unroll
        for (int i = 0; i < 14; ++i) pr[i] = *(const u32x4*)(gsrc + SCAN_CHUNK + (size_t)(pt + 256 * i) * 16);
        __syncthreads();
#pragma unroll 1
        for (int n = 0; n < 128; ++n) {
            if (n + 1 < 128) {
                const int nb = ((n + 1) & 1) * SC_BUF;
#pragma unroll
                for (int i = 0; i < 14; ++i) *(LAS u32x4*)(lds + nb + (pt + 256 * i) * 16) = pr[i];
                if (n + 2 < 128) {
#pragma unroll
                    for (int i = 0; i < 14; ++i) pr[i] = *(const u32x4*)(gsrc + (size_t)(n + 2) * SCAN_CHUNK + (size_t)(pt + 256 * i) * 16);
                }
            }
            if (n >= 1) scan_post(p, lds, bh, n - 1, pt);
            __syncthreads();
        }
        scan_post(p, lds, bh, 127, pt);
    } else {
        const int sl = wave;
        f32x16 S[4];
#pragma unroll
        for (int i = 0; i < 4; ++i) S[i] = zero16();
        const float* GL = (const float*)(p.ws + WS_GL) + bh * 128;
        float gl_next = GL[0];
        u32x4 ucur[2][2], unxt[2][2];
#pragma unroll
        for (int Rc = 0; Rc < 2; ++Rc) { const unsigned char* up = gsrc + 57344 + ((size_t)(Rc * 4 + sl) * 64 + lane) * 32; ucur[Rc][0] = *(const u32x4*)up; ucur[Rc][1] = *(const u32x4*)(up + 16); unxt[Rc][0] = ucur[Rc][0]; unxt[Rc][1] = ucur[Rc][1]; }
        __syncthreads();
#pragma unroll 1
        for (int n = 0; n < 128; ++n) {
            const LAS unsigned char* cb = lds + (n & 1) * SC_BUF + lane * 16;
            const float gl = gl_next;
            if (n + 1 < 128) {
                gl_next = GL[n + 1];
#pragma unroll
                for (int Rc = 0; Rc < 2; ++Rc) { const unsigned char* up = gsrc + (size_t)(n + 1) * SCAN_CHUNK + 57344 + ((size_t)(Rc * 4 + sl) * 64 + lane) * 32; unxt[Rc][0] = *(const u32x4*)up; unxt[Rc][1] = *(const u32x4*)(up + 16); }
            }
            f32x16 va[2], oa[2];
#pragma unroll
            for (int Rc = 0; Rc < 2; ++Rc) {
                float f[16]; unpack8(ucur[Rc][0], f); unpack8(ucur[Rc][1], f + 8);
#pragma unroll
                for (int i = 0; i < 16; ++i) va[Rc][i] = f[i];
                oa[Rc] = zero16();
            }
#pragma unroll
            for (int s = 0; s < 8; ++s) {
                const bf16x8 sb = (s & 1) ? pack8<1>(S[s >> 1]) : pack8<0>(S[s >> 1]);
                const bf16x8 w0 = *(const LAS bf16x8*)(cb + (0 * 8 + s) * 1024), w1 = *(const LAS bf16x8*)(cb + (1 * 8 + s) * 1024);
                const bf16x8 q0 = *(const LAS bf16x8*)(cb + 16384 + (0 * 8 + s) * 1024), q1 = *(const LAS bf16x8*)(cb + 16384 + (1 * 8 + s) * 1024);
                va[0] = MFMA32(w0, sb, va[0]); va[1] = MFMA32(w1, sb, va[1]); oa[0] = MFMA32(q0, sb, oa[0]); oa[1] = MFMA32(q1, sb, oa[1]);
            }
            bf16x8 vB[4];
            vB[0] = pack8<0>(va[0]); vB[1] = pack8<1>(va[0]); vB[2] = pack8<0>(va[1]); vB[3] = pack8<1>(va[1]);
            LAS unsigned char* ob = lds + SC_OB + (n & 1) * 16384 + (sl * 32 + r) * 2;
#pragma unroll
            for (int Rc = 0; Rc < 2; ++Rc) {
#pragma unroll
                for (int ks = 0; ks < 4; ++ks) { const bf16x8 af = *(const LAS bf16x8*)(cb + 49152 + (Rc * 4 + ks) * 1024); oa[Rc] = MFMA32(af, vB[ks], oa[Rc]); }
#pragma unroll
                for (int i = 0; i < 16; ++i) *(LAS unsigned short*)(ob + (32 * Rc + crow(i, h)) * 256) = f2bf(oa[Rc][i]);
            }
#pragma unroll
            for (int Rd = 0; Rd < 4; ++Rd) {
#pragma unroll
                for (int i = 0; i < 16; ++i) S[Rd][i] *= gl;
#pragma unroll
                for (int ks = 0; ks < 4; ++ks) { const bf16x8 kf = *(const LAS bf16x8*)(cb + 32768 + (Rd * 4 + ks) * 1024); S[Rd] = MFMA32(kf, vB[ks], S[Rd]); }
            }
#pragma unroll
            for (int Rc = 0; Rc < 2; ++Rc) { ucur[Rc][0] = unxt[Rc][0]; ucur[Rc][1] = unxt[Rc][1]; }
            __syncthreads();
        }
    }
}

constexpr int AT_STAGE = 35840, AT_K1 = 9216, AT_V = 18432, AT_X = 0, AT_OST = 71680, AT_QSLOT = 147456;
DI void attn_unit(const Params& p, LAS unsigned char* lds, int bh, int qb, float lam, int tid, int lane, int wave) {
    asm volatile("" : "+v"(tid), "+v"(lane));
    const int r = lane & 31, h = lane >> 5, b = bh >> 2, hd = bh & 3;
    const int sub = wave & 1, qg = wave >> 1;
    const int q0 = qb * 128, NT = 2 * qb + 2, my_nt = 2 * qb + (qg >> 1) + 1;
    const bf16* Qd = (const bf16*)(p.ws + WS_QD); const bf16* Kd = (const bf16*)(p.ws + WS_KD); const bf16* VT = (const bf16*)(p.ws + WS_VT);
    bf16x8 qf[4];
#pragma unroll
    for (int s = 0; s < 4; ++s) qf[s] = *(const bf16x8*)(Qd + ((size_t)(bh * 2 + sub) * SEQ + q0 + 32 * qg + r) * 64 + 16 * s + 8 * h);
    const bf16* ksrc[2]; int kdst[2]; const bf16* vsrc[2]; int vdst[2];
#pragma unroll
    for (int i = 0; i < 2; ++i) { const int pc = tid + 512 * i; const int ksub = pc >> 9, key = (pc >> 3) & 63, ch = pc & 7;
        ksrc[i] = Kd + ((size_t)(bh * 2 + ksub) * SEQ + key) * 64 + ch * 8; kdst[i] = ksub * AT_K1 + key * 144 + ch * 16;
        const int dv = pc >> 3, c16 = pc & 7;
        vsrc[i] = VT + ((size_t)bh * 128 + dv) * SEQ + c16 * 8; vdst[i] = AT_V + dv * 136 + c16 * 16; }
    u32x4 kreg[2], vreg[2], kreg2[2], vreg2[2];
#pragma unroll
    for (int i = 0; i < 2; ++i) { kreg[i] = *(const u32x4*)(ksrc[i]); vreg[i] = *(const u32x4*)(vsrc[i]); }
#pragma unroll
    for (int i = 0; i < 2; ++i) { *(LAS u32x4*)(lds + kdst[i]) = kreg[i];
        *(LAS u32x2*)(lds + vdst[i]) = (u32x2){vreg[i].x, vreg[i].y}; *(LAS u32x2*)(lds + vdst[i] + 8) = (u32x2){vreg[i].z, vreg[i].w}; }
#pragma unroll
    for (int i = 0; i < 2; ++i) { kreg[i] = *(const u32x4*)(ksrc[i] + (size_t)64 * 64); vreg[i] = *(const u32x4*)(vsrc[i] + (size_t)64); }
    __syncthreads();
    f32x16 O[4];
#pragma unroll
    for (int c = 0; c < 4; ++c) O[c] = zero16();
    float mref = 0.f, lrun = 0.f;
#define AT_COMPUTE(kt, cur) do { \
        if ((kt) < my_nt) { \
            f32x16 p0, p1; \
            const LAS unsigned char* kb = lds + (cur) + sub * AT_K1 + r * 144 + h * 16; \
            const LAS unsigned char* vb = lds + (cur) + AT_V + r * 136 + h * 8; \
            bf16x8 kf0[4], kf1[4]; \
_Pragma("unroll") \
            for (int s = 0; s < 4; ++s) { kf0[s] = *(const LAS bf16x8*)(kb + s * 32); kf1[s] = *(const LAS bf16x8*)(kb + 32 * 144 + s * 32); } \
            s16x4 vlo[4], vhi[4]; \
_Pragma("unroll") \
            for (int ks = 0; ks < 4; ++ks) { vlo[ks] = *(const LAS s16x4*)(vb + ks * 32); vhi[ks] = *(const LAS s16x4*)(vb + ks * 32 + 16); } \
            __builtin_amdgcn_sched_barrier(0); \
            p0 = MFMA32(kf0[0], qf[0], zero16()); p1 = MFMA32(kf1[0], qf[0], zero16()); \
_Pragma("unroll") \
            for (int s = 1; s < 4; ++s) { p0 = MFMA32(kf0[s], qf[s], p0); p1 = MFMA32(kf1[s], qf[s], p1); } \
            float rs = 0.f; \
            if (__any(mref != 0.f)) { \
_Pragma("unroll") \
            for (int i = 0; i < 16; ++i) { p0[i] -= mref; p1[i] -= mref; } \
            } \
_Pragma("unroll") \
            for (int i = 0; i < 16; ++i) { p0[i] = __builtin_amdgcn_exp2f(p0[i]); p1[i] = __builtin_amdgcn_exp2f(p1[i]); } \
            float rsa = 0.f, rsb = 0.f;                             \
_Pragma("unroll") \
            for (int i = 0; i < 16; ++i) { rsa += p0[i]; asm volatile("" : "+v"(rsa)); rsb += p1[i]; asm volatile("" : "+v"(rsb)); } \
            rs = rsa + rsb; \
            lrun += rs; \
            if (__any(rs > 1048576.f)) {        \
                float mxa = max3f(p0[0], p0[1], p1[0]), mxb = max3f(p0[2], p0[3], p1[1]); mxa = max3f(mxa, p1[2], p1[3]); \
_Pragma("unroll") \
                for (int i = 4; i < 16; i += 4) { mxa = max3f(mxa, p0[i], p0[i + 1]); mxb = max3f(mxb, p0[i + 2], p0[i + 3]); mxa = max3f(mxa, p1[i], p1[i + 1]); mxb = max3f(mxb, p1[i + 2], p1[i + 3]); } \
                float mx = fmaxf(mxa, mxb); mx = fmaxf(mx, __shfl_xor(mx, 32)); \
                const float d = fmaxf(floorf(__builtin_amdgcn_logf(fmaxf(mx, 1.f))), 0.f), alpha = __builtin_amdgcn_exp2f(-d); \
                mref += d; lrun *= alpha; \
_Pragma("unroll") \
                for (int c = 0; c < 4; ++c) \
_Pragma("unroll") \
                    for (int i = 0; i < 16; ++i) O[c][i] *= alpha; \
_Pragma("unroll") \
                for (int i = 0; i < 16; ++i) { p0[i] *= alpha; p1[i] *= alpha; } \
            } \
            bf16x8 pf[4]; pf[0] = pack8<0>(p0); pf[1] = pack8<1>(p0); pf[2] = pack8<0>(p1); pf[3] = pack8<1>(p1); \
_Pragma("unroll") \
            for (int c = 0; c < 4; ++c) { \
                bf16x8 vf[4]; \
_Pragma("unroll") \
                for (int ks = 0; ks < 4; ++ks) vf[ks] = __builtin_shufflevector(vlo[ks], vhi[ks], 0, 1, 2, 3, 4, 5, 6, 7); \
                if (c < 3) { \
_Pragma("unroll") \
                    for (int ks = 0; ks < 4; ++ks) { vlo[ks] = *(const LAS s16x4*)(vb + (c + 1) * 32 * 136 + ks * 32); vhi[ks] = *(const LAS s16x4*)(vb + (c + 1) * 32 * 136 + ks * 32 + 16); } \
                } \
                __builtin_amdgcn_sched_barrier(0); \
_Pragma("unroll") \
                for (int ks = 0; ks < 4; ++ks) O[c] = MFMA32(vf[ks], pf[ks], O[c]); \
                __builtin_amdgcn_sched_barrier(0); \
            } \
        } \
    } while (0)
#define AT_LOAD(KR, VR, t) do { _Pragma("unroll") for (int i = 0; i < 2; ++i) { KR[i] = *(const u32x4*)(ksrc[i] + (size_t)(t) * 64 * 64); VR[i] = *(const u32x4*)(vsrc[i] + (size_t)(t) * 64); } } while (0)
#define AT_WRITE(KR, VR, slot) do { _Pragma("unroll") for (int i = 0; i < 2; ++i) { *(LAS u32x4*)(lds + (slot) + kdst[i]) = KR[i]; \
        *(LAS u32x2*)(lds + (slot) + vdst[i]) = (u32x2){VR[i].x, VR[i].y}; *(LAS u32x2*)(lds + (slot) + vdst[i] + 8) = (u32x2){VR[i].z, VR[i].w}; } } while (0)
    if (wave >= 4) __builtin_amdgcn_s_setprio(1);
#pragma unroll 1
    for (int kt = 0; kt < NT; kt += 2) {
        if (kt + 2 < NT) AT_LOAD(kreg2, vreg2, kt + 2);
        AT_COMPUTE(kt, 0);
        AT_WRITE(kreg, vreg, AT_STAGE);
        __syncthreads();
        if (kt + 3 < NT) AT_LOAD(kreg, vreg, kt + 3);
        AT_COMPUTE(kt + 1, AT_STAGE);
        if (kt + 2 < NT) AT_WRITE(kreg2, vreg2, 0);
        __syncthreads();
    }
#undef AT_COMPUTE
#undef AT_LOAD
#undef AT_WRITE
    __builtin_amdgcn_s_setprio(0);
    const float lt = lrun + __shfl_xor(lrun, 32);
    const float inv = (sub ? lam : 1.f) / lt;
    LAS float* X = (LAS float*)(lds + AT_X + qg * 16384);
    if (sub == 1) {
#pragma unroll
        for (int c = 0; c < 4; ++c)
#pragma unroll
            for (int i = 0; i < 16; ++i) X[(c * 16 + i) * 64 + lane] = O[c][i] * inv;
    }
    __syncthreads();
    if (sub == 0) {
        float ssq = 0.f;
#pragma unroll
        for (int c = 0; c < 4; ++c)
#pragma unroll
            for (int i = 0; i < 16; ++i) { const float o = O[c][i] * inv - X[(c * 16 + i) * 64 + lane]; O[c][i] = o; ssq += o * o; }
        ssq += __shfl_xor(ssq, 32);
        const float rstd = rsqrtf(ssq * (1.f / 128.f) + 1e-6f);
        LAS unsigned char* st = lds + AT_OST + qg * 8704;
#pragma unroll
        for (int c = 0; c < 4; ++c)
#pragma unroll
            for (int i = 0; i < 16; ++i) *(LAS unsigned short*)(st + r * 272 + (32 * c + crow(i, h)) * 2) = f2bf(O[c][i] * rstd);
        asm volatile("s_waitcnt lgkmcnt(0)" ::: "memory");
        const bf16* BGt = (const bf16*)(p.ws + WS_PROJ + (size_t)7 * PROJ_SUB);
        bf16* MX = (bf16*)(p.ws + WS_MIXED);
#pragma unroll
        for (int it = 0; it < 8; ++it) {
            const int row = it * 4 + (lane >> 4), ch = lane & 15;
            const u32x4 ov = *(const LAS u32x4*)(st + row * 272 + ch * 16);
            const size_t m = (size_t)b * SEQ + q0 + 32 * qg + row;
            const u32x4 gv = *(const u32x4*)(BGt + m * 512 + hd * 128 + ch * 8);
            float of[8], gf[8]; unpack8(ov, of); unpack8(gv, gf);
            const f32x4 s0 = *(const f32x4*)(p.subln_g + ch * 8), s1 = *(const f32x4*)(p.subln_g + ch * 8 + 4);
            const float sg[8] = {s0.x, s0.y, s0.z, s0.w, s1.x, s1.y, s1.z, s1.w};
            float y[8];
#pragma unroll
            for (int e = 0; e < 8; ++e) y[e] = of[e] * sg[e] * 0.8f * silu_f(gf[e]);
            u32x4 o; o.x = pk2(y[0], y[1]); o.y = pk2(y[2], y[3]); o.z = pk2(y[4], y[5]); o.w = pk2(y[6], y[7]);
            *(u32x4*)(MX + m * 1024 + 512 + hd * 128 + ch * 8) = o;
        }
    }
}

DI unsigned xb_xcc_id();
DI void p4_phase(const Params& p, LAS unsigned char* lds, int tid, int lane, int wave, int mode = 0) {
    const float lam = __expf(wave_sum(p.lq1[lane] * p.lk1[lane])) - __expf(wave_sum(p.lq2[lane] * p.lk2[lane])) + 0.2f;
    const int myx = (int)(xb_xcc_id() & 7u);
    LAS int* qslot = (LAS int*)(lds + AT_QSLOT);
    for (int qq = 0; qq < 8; ++qq) {
        const int x = (myx + qq) & 7;
        unsigned* ctr = (unsigned*)(p.ws + WS_CTL) + (mode * 8 + x) * 32;
        for (;;) {
            __syncthreads();
            if (tid == 0) *qslot = (int)atomicAdd(ctr, 1u);
            __syncthreads();
            int item = *qslot;
            if (mode == 2) item += 2;
            if (item >= (mode == 1 ? 2 : 130)) break;
            if (item < 2) scan_job(p, lds, 2 * x + item, tid, lane, wave);
            else { const int u = item - 2; attn_unit(p, lds, 2 * x + (u & 1), 63 - (u >> 1), lam, tid, lane, wave); }
        }
    }
}

DI void p5_phase(const Params& p, int tid, int lane, int wave) {
    const float* OG = (const float*)(p.ws + WS_OG);
    const bf16* AG = (const bf16*)(p.ws + WS_PROJ + (size_t)3 * PROJ_SUB);
    bf16* MX = (bf16*)(p.ws + WS_MIXED);
    const int sub = lane >> 4, l16 = lane & 15;
    f32x4 g0 = *(const f32x4*)(p.gdn_g + l16 * 8), g1 = *(const f32x4*)(p.gdn_g + l16 * 8 + 4);
    const float gg[8] = {g0.x, g0.y, g0.z, g0.w, g1.x, g1.y, g1.z, g1.w};
    const int gw = blockIdx.x * 8 + wave, NGW = gridDim.x * 8;
    for (int rowi = gw * 4 + sub; rowi < MT * 4; rowi += NGW * 4) {
        const size_t off = (size_t)rowi * 128 + l16 * 8;
        const f32x4 a = *(const f32x4*)(OG + off), c2 = *(const f32x4*)(OG + off + 4);
        float v[8] = {a.x, a.y, a.z, a.w, c2.x, c2.y, c2.z, c2.w};
        float ss = 0.f;
#pragma unroll
        for (int e = 0; e < 8; ++e) ss += v[e] * v[e];
        ss += __shfl_xor(ss, 1); ss += __shfl_xor(ss, 2); ss += __shfl_xor(ss, 4); ss += __shfl_xor(ss, 8);
        const float rstd = rsqrtf(ss * (1.f / 128.f) + 1e-6f);
        const u32x4 gv = *(const u32x4*)(AG + off);
        float gf[8]; unpack8(gv, gf);
        float y[8];
#pragma unroll
        for (int e = 0; e < 8; ++e) y[e] = v[e] * rstd * gg[e] * silu_f(gf[e]);
        u32x4 o; o.x = pk2(y[0], y[1]); o.y = pk2(y[2], y[3]); o.z = pk2(y[4], y[5]); o.w = pk2(y[6], y[7]);
        const size_t m = (size_t)(rowi >> 2); const int hd = rowi & 3;
        *(u32x4*)(MX + m * 1024 + hd * 128 + l16 * 8) = o;
    }
}

struct EpiOut {
    static constexpr bool PERM = true, AFTER_DRAIN = false;
    const float* x; float* out; const float* gate;
    __device__ __forceinline__ void operator()(const pg8::f32x4 (&acc)[2][2][4][2], const pg8::Unit& u, int wr, int wc, int fr, int fq) const {
        const int col0 = u.pn * 256 + wc * 32 + 8 * fq;
        const int b = (u.pm * 256) / SEQ;
        pg8::f32x4 gv[2][2];
#pragma unroll
        for (int bj = 0; bj < 2; ++bj)
#pragma unroll
            for (int n = 0; n < 2; ++n) gv[bj][n] = *(const pg8::f32x4*)(gate + b * 1024 + col0 + bj * 128 + n * 4);
#pragma unroll
        for (int ai = 0; ai < 2; ++ai)
#pragma unroll
            for (int m = 0; m < 4; ++m) { const size_t off = (size_t)(u.pm * 256 + ai * 128 + wr * 64 + m * 16 + fr) * DM + col0;
#pragma unroll
                for (int bj = 0; bj < 2; ++bj)
#pragma unroll
                    for (int n = 0; n < 2; ++n) { const pg8::f32x4 xv = *(const pg8::f32x4*)(x + off + bj * 128 + n * 4);
                        *(pg8::f32x4*)(out + off + bj * 128 + n * 4) = xv + gv[bj][n] * acc[ai][bj][m][n]; } }
    }
};

#define GAS __attribute__((address_space(1)))
#define XB_TMO      128
#define XB_XCNT(j)  (256  + 64 * (j))
#define XB_XSUB(j)  (1280 + 64 * (j))
#define XB_XGEN(j)  (2304 + 64 * (j))
#define XB_TOP      3328
#define XB_TOPGEN   3392
#define XCD_BAR_WORDS 3456
#define XB_SPIN_CAP (1u << 18)

__device__ __forceinline__ unsigned xb_ld(unsigned* p)              { return __hip_atomic_load(p, __ATOMIC_RELAXED, __HIP_MEMORY_SCOPE_AGENT); }
__device__ __forceinline__ unsigned xb_add(unsigned* p, unsigned v) { return __hip_atomic_fetch_add(p, v, __ATOMIC_RELAXED, __HIP_MEMORY_SCOPE_AGENT); }
__device__ __forceinline__ unsigned xb_xcc_id() { return (unsigned)__builtin_amdgcn_s_getreg((3 << 11) | 20) & 0xFu; }
#define XB_SPIN(cond, bar) do { unsigned _sp = 0; while (cond) { __builtin_amdgcn_s_sleep(1); \
    if ((++_sp & 255u) == 0u) { if (xb_ld(&(bar)[XB_TMO])) break; if (_sp > XB_SPIN_CAP) { atomicAdd(&(bar)[XB_TMO], 1u); break; } } } } while (0)

struct XcdBarrier {
    unsigned* bar; unsigned x;
    volatile LAS unsigned* st;
};

__device__ __forceinline__ XcdBarrier xcd_barrier_post(unsigned* bar, volatile LAS unsigned* st) {
    XcdBarrier b; b.bar = bar; b.x = xb_xcc_id(); b.st = st;
    if (threadIdx.x == 0) (void)xb_add(&bar[XB_XCNT(b.x)], 1u);
    return b;
}
__device__ __forceinline__ void xcd_barrier_complete(unsigned* bar, unsigned x, unsigned& nloc, unsigned& nx) {
    const unsigned G = gridDim.x * gridDim.y * gridDim.z;
    unsigned sum, cnt, mine, sp = 0u;
    for (;;) {
        sum = 0u; cnt = 0u; mine = 0u;
#pragma unroll
        for (unsigned j = 0; j < 16; ++j) { const unsigned c = xb_ld(&bar[XB_XCNT(j)]); sum += c; cnt += (c > 0u) ? 1u : 0u; mine = (j == x) ? c : mine; }
        if (sum == G) break;
        __builtin_amdgcn_s_sleep(1);
        if ((++sp & 255u) == 0u) { if (xb_ld(&bar[XB_TMO])) break; if (sp > XB_SPIN_CAP) { atomicAdd(&bar[XB_TMO], 1u); break; } }
    }
    nloc = mine > 0u ? mine : 1u; nx = cnt > 0u ? cnt : 1u;
}

__device__ __forceinline__ void xcd_barrier(const XcdBarrier& b) {
    asm volatile("s_waitcnt vmcnt(0)" ::: "memory");
    __syncthreads();
    if (threadIdx.x == 0) {
        unsigned* bar = b.bar;
        __builtin_amdgcn_s_waitcnt(0);
        unsigned nloc = b.st[0], nx = b.st[1];
        if (nloc == 0u) { xcd_barrier_complete(bar, b.x, nloc, nx); b.st[0] = nloc; b.st[1] = nx; }
        const unsigned old = xb_add(&bar[XB_XSUB(b.x)], 1u);
        const unsigned gen = old / nloc;
        if (old + 1u == (gen + 1u) * nloc) {
            __builtin_amdgcn_fence(__ATOMIC_RELEASE, "agent");
            asm volatile("s_waitcnt vmcnt(0)" ::: "memory");
            const unsigned og = xb_add(&bar[XB_TOP], 1u);
            const unsigned tg = og / nx;
            if (og + 1u == (tg + 1u) * nx) xb_add(&bar[XB_TOPGEN], 1u);
            else XB_SPIN(xb_ld(&bar[XB_TOPGEN]) == tg, bar);
            __builtin_amdgcn_fence(__ATOMIC_ACQUIRE, "agent");
            xb_add(&bar[XB_XGEN(b.x)], 1u);
            asm volatile("s_waitcnt vmcnt(0)" ::: "memory");
        } else {
            XB_SPIN(xb_ld(&bar[XB_XGEN(b.x)]) == gen, bar);
            __builtin_amdgcn_fence(__ATOMIC_ACQUIRE, "agent");
            asm volatile("s_waitcnt vmcnt(0)" ::: "memory");
        }
    }
    __syncthreads();
}

template <int PH_LO, int PH_HI, int VARIANT = 0>
__global__ void __launch_bounds__(NTHREADS) fwd_kernel(Params p) {
    extern __shared__ __attribute__((aligned(16))) unsigned char lds_raw[];
    LAS unsigned char* lds = (LAS unsigned char*)lds_raw;
    int tid = threadIdx.x, lane = tid & 63; const int wave = __builtin_amdgcn_readfirstlane(tid >> 6);
#define LAUNDER() asm volatile("" : "+v"(tid), "+v"(lane))
#define PH(k) (PH_LO <= (k) && (k) < PH_HI)
    constexpr bool FUSED = (PH_HI - PH_LO) > 1;
    XcdBarrier bar; bar.bar = nullptr; bar.x = 0; bar.st = nullptr;
    if (FUSED) {
        volatile LAS unsigned* misc = (volatile LAS unsigned*)(lds + 147456 + 32);
        if (tid < 2) misc[tid] = 0u;
        __syncthreads();
        bar = xcd_barrier_post((unsigned*)(p.ws + WS_CTL) + 1024, misc);
    }
    if (FUSED && p.ws == nullptr) cg::this_grid().sync();
#define SEAM(k) do { if (PH(k) && PH((k) + 1)) xcd_barrier(bar); } while (0)
    if (PH(0)) p0_phase(p, lds, tid, lane, wave);
    SEAM(0);
    LAUNDER();
    if (PH(1)) p1_phase(p, lds, tid, lane, wave);
    SEAM(1);
    LAUNDER();
    if (PH(2)) {
        pg8::Gemm g{(const pg8::bf16_t*)(p.ws + WS_XN), (const pg8::bf16_t*)(p.ws + WS_WIN), MT, 4096, 1024};
        pg8::StaticOrder S; S.init(MT, 4096, gridDim.x, (int)blockIdx.x);
        pg8::EpiBf16<0> E{(pg8::bf16_t*)(p.ws + WS_PROJ), 512, nullptr, 512, PROJ_SUB / 2, 1.f};
        pg8::gemm_phase<pg8::EpiBf16<0>, pg8::StaticOrder, true, true>(lds, g, S, E);
        __syncthreads();
    }
    SEAM(2);
    LAUNDER();
    if (PH(3)) {
        if (VARIANT != 4) gdn_prep_all(p, lds, tid, lane, wave, VARIANT);
        __syncthreads();
        if (VARIANT != 3 && VARIANT != 5 && VARIANT != 6) for (int it = blockIdx.x; it < 2048; it += gridDim.x) diff_prep_item(p, lds, it, tid, lane, wave);
    }
    SEAM(3);
    if (PH(4)) p4_phase(p, lds, tid, lane, wave, VARIANT);
    SEAM(4);
    LAUNDER();
    if (PH(6)) {
        pg8::Gemm g{(const pg8::bf16_t*)(p.ws + WS_MIXED), (const pg8::bf16_t*)(p.ws + WS_WOUT), MT, 1024, 1024};
        pg8::StaticOrder S; S.init(MT, 1024, gridDim.x, (int)blockIdx.x);
        EpiOut E{p.x, p.out, (const float*)(p.ws + WS_GATE)};
        pg8::gemm_phase<EpiOut, pg8::StaticOrder, true, true>(lds, g, S, E);
    }
#undef PH
#undef SEAM
}

#ifndef N_LAUNCH_MODE
#define N_LAUNCH_MODE 1
#endif

template <int LO, int HI, int VARIANT = 0> static void launch_range(const Params& p, int grid, hipStream_t stream, bool coop) {
    auto kfn = fwd_kernel<LO, HI, VARIANT>;
    (void)hipFuncSetAttribute((const void*)kfn, hipFuncAttributeMaxDynamicSharedMemorySize, LDS_BYTES);
    if (coop) {
        Params pp = p; void* args[] = {&pp};
        hipError_t e = hipLaunchCooperativeKernel((const void*)kfn, dim3(grid), dim3(NTHREADS), args, LDS_BYTES, stream);
        if (e != hipSuccess) fprintf(stderr, "cooperative launch failed: %s (grid %d)\n", hipGetErrorString(e), grid);
    } else {
        hipLaunchKernelGGL(kfn, dim3(grid), dim3(NTHREADS), LDS_BYTES, stream, p);
    }
}

extern "C" void kernel_launch(void* const* d_in, const int* in_sizes, int n_in, void* d_out, int out_size, void* d_ws, size_t ws_size, hipStream_t stream) {
    static int grid = 0;
    if (grid == 0) {
        if (n_in != 19 || ws_size < WS_END) { fprintf(stderr, "kernel_launch: unexpected n_in %d or ws_size %zu (< %zu)\n", n_in, ws_size, (size_t)WS_END); grid = -1; return; }
        int dev = 0, cus = 0, per_cu = 0;
        hipGetDevice(&dev); hipDeviceGetAttribute(&cus, hipDeviceAttributeMultiprocessorCount, dev);
        auto kfn = fwd_kernel<0, 7>;
        (void)hipFuncSetAttribute((const void*)kfn, hipFuncAttributeMaxDynamicSharedMemorySize, LDS_BYTES);
        if (hipOccupancyMaxActiveBlocksPerMultiprocessor(&per_cu, (const void*)kfn, NTHREADS, LDS_BYTES) != hipSuccess || per_cu < 1) { per_cu = 1; (void)hipGetLastError(); }
        grid = cus * per_cu;
        if (grid > 256) grid = 256;
    }
    if (grid < 0) return;
    Params p{};
    p.x = (const float*)d_in[0]; p.c = (const float*)d_in[1]; p.pos = (const int*)d_in[2]; p.norm_g = (const float*)d_in[3]; p.w_ada = (const float*)d_in[4];
    p.b_ada = (const float*)d_in[5]; p.w_in = (const float*)d_in[6]; p.conv_w = (const float*)d_in[7]; p.a_log = (const float*)d_in[8]; p.dt_bias = (const float*)d_in[9];
    p.gdn_g = (const float*)d_in[10]; p.qn_g = (const float*)d_in[11]; p.kn_g = (const float*)d_in[12]; p.lq1 = (const float*)d_in[13]; p.lk1 = (const float*)d_in[14];
    p.lq2 = (const float*)d_in[15]; p.lk2 = (const float*)d_in[16]; p.subln_g = (const float*)d_in[17]; p.w_out = (const float*)d_in[18];
    p.out = (float*)d_out; p.ws = (unsigned char*)d_ws;
#if N_LAUNCH_MODE == 1
    (void)hipMemsetAsync((unsigned char*)d_ws + WS_CTL + 4096, 0, XCD_BAR_WORDS * 4, stream);
    launch_range<0, 7>(p, grid, stream, true);
#else
#ifndef PROBE_DUP
#define PROBE_DUP 0
#endif
#ifndef PROBE_SCAN
#define PROBE_SCAN 0
#endif
    for (int rep = 0; rep < 1 + ((PROBE_DUP >> 0) & 1); ++rep) launch_range<0, 1>(p, grid, stream, false);
    for (int rep = 0; rep < 1 + ((PROBE_DUP >> 1) & 1); ++rep) launch_range<1, 2>(p, grid, stream, false);
    for (int rep = 0; rep < 1 + ((PROBE_DUP >> 2) & 1); ++rep) launch_range<2, 3>(p, grid, stream, false);
#if PROBE_SCAN == 3
    launch_range<3, 4, 3>(p, grid, stream, false);
#elif PROBE_SCAN == 4
    launch_range<3, 4, 4>(p, grid, stream, false);
#elif PROBE_SCAN == 5
    launch_range<3, 4, 5>(p, grid, stream, false);
#elif PROBE_SCAN == 6
    launch_range<3, 4, 6>(p, grid, stream, false);
#endif
    for (int rep = 0; rep < 1 + ((PROBE_DUP >> 3) & 1); ++rep) launch_range<3, 4>(p, grid, stream, false);
#if PROBE_SCAN == 1
    launch_range<4, 5, 1>(p, grid, stream, false);
#elif PROBE_SCAN == 2
    launch_range<4, 5, 2>(p, grid, stream, false);
#endif
    launch_range<4, 5>(p, grid, stream, false);
    for (int rep = 0; rep < 1 + ((PROBE_DUP >> 5) & 1); ++rep) launch_range<5, 6>(p, grid, stream, false);
    for (int rep = 0; rep < 1 + ((PROBE_DUP >> 6) & 1); ++rep) launch_range<6, 7>(p, grid, stream, false);
#endif
}
```
